# Optimizing an MI355X kernel written in HIP

```python
import math
import jax, jax.numpy as jnp
from jax import lax
import numpy as np

D_MODEL = 2048
BATCH = 1
SEQ = 8192
DEPTH = 1

ATT_HEADS = 16
ATT_KV_HEADS = 2
HEAD_DIM = 64
ATT_WIDTH = ATT_HEADS * HEAD_DIM
KV_WIDTH = ATT_KV_HEADS * HEAD_DIM
WINDOW = 128
ATT_BLOCK = 128
ROT_DIM = HEAD_DIM // 4
ROPE_THETA = 500000.0
SSD_HEADS = 16
SSD_HEAD_DIM = 64
SSD_WIDTH = SSD_HEADS * SSD_HEAD_DIM
SSD_GROUPS = 2
SSD_STATE = 128
CONV_WIDTH = 4
SSD_CHUNK = 128
XBC_WIDTH = SSD_WIDTH + 2 * SSD_GROUPS * SSD_STATE
MIX_WIDTH = ATT_WIDTH + SSD_WIDTH
OFF_Q = ATT_WIDTH
OFF_K = OFF_Q + KV_WIDTH
OFF_V = OFF_K + KV_WIDTH
OFF_Z = OFF_V + SSD_WIDTH
OFF_XBC = OFF_Z + XBC_WIDTH
IN_WIDTH = OFF_XBC + SSD_HEADS
N_KEYS = 128
N_EXPERTS = N_KEYS * N_KEYS
PEER_HEADS = 8
PEER_KEY_DIM = 128
PEER_TOPK = 16
PEER_BLOCK = 128
ALPHA = (2.0 * DEPTH) ** 0.25
BETA = (8.0 * DEPTH) ** -0.25
LN_EPS = 1e-5
N_MOD = 6

kernel_name = "hymba_swa_ssd_peer_deepnorm_adaln"


def layer_norm(x, g, b):
    xf = x.astype(jnp.float32)
    mu = jnp.mean(xf, -1, keepdims=True)
    var = jnp.mean(jnp.square(xf - mu), -1, keepdims=True)
    return ((xf - mu) * lax.rsqrt(var + LN_EPS) * g.astype(jnp.float32) + b.astype(jnp.float32)).astype(x.dtype)


def rope_tables(positions):
    inv = ROPE_THETA ** (-jnp.arange(0, ROT_DIM, 2, dtype=jnp.float32) / ROT_DIM)
    ang = positions.astype(jnp.float32)[..., None] * inv
    return jnp.cos(ang), jnp.sin(ang)


def apply_partial_rope(t, cos, sin):
    half = ROT_DIM // 2
    t1 = t[..., :half].astype(jnp.float32)
    t2 = t[..., half:ROT_DIM].astype(jnp.float32)
    rot = jnp.concatenate([t1 * cos - t2 * sin, t2 * cos + t1 * sin], -1).astype(t.dtype)
    return jnp.concatenate([rot, t[..., ROT_DIM:]], -1)


def sliding_window_attention(q, k, v, sinks):
    B, S = q.shape[0], q.shape[1]
    nb = S // ATT_BLOCK
    G = ATT_HEADS // ATT_KV_HEADS
    qb = q.reshape(B, nb, ATT_BLOCK, ATT_KV_HEADS, G, HEAD_DIM)

    def band(t):
        tb = t.reshape(B, nb, ATT_BLOCK, ATT_KV_HEADS, HEAD_DIM)
        prev = jnp.pad(tb[:, :-1], ((0, 0), (1, 0), (0, 0), (0, 0), (0, 0)))
        return jnp.concatenate([prev, tb], axis=2)

    kb, vb = band(k), band(v)
    logits = jnp.einsum('bnqhgd,bnkhd->bnhgqk', qb, kb,
                        preferred_element_type=jnp.float32) * (HEAD_DIM ** -0.5)
    blk = jnp.arange(nb)[:, None, None] * ATT_BLOCK
    qpos = blk + jnp.arange(ATT_BLOCK)[None, :, None]
    kpos = blk - ATT_BLOCK + jnp.arange(2 * ATT_BLOCK)[None, None, :]
    rel = qpos - kpos
    valid = (rel >= 0) & (rel < WINDOW) & (kpos >= 0)
    logits = jnp.where(valid[None, :, None, None], logits, -jnp.inf)
    sink = sinks.astype(jnp.float32).reshape(1, 1, ATT_KV_HEADS, G, 1, 1)
    m = jnp.maximum(jnp.max(logits, -1, keepdims=True), sink)
    p = jnp.exp(logits - m)
    probs = (p / (jnp.sum(p, -1, keepdims=True) + jnp.exp(sink - m))).astype(v.dtype)
    out = jnp.einsum('bnhgqk,bnkhd->bnqhgd', probs, vb)
    return out.reshape(B, S, ATT_WIDTH)


def causal_depthwise_conv(u, w, b):
    out = lax.conv_general_dilated(u, w[:, None, :], window_strides=(1,),
                                   padding=[(CONV_WIDTH - 1, 0)],
                                   dimension_numbers=('NWC', 'WIO', 'NWC'),
                                   feature_group_count=u.shape[-1])
    return out + b


def ssd_chunked(xs, dt, A, Bm, Cm):
    Bsz, S = xs.shape[0], xs.shape[1]
    nc = S // SSD_CHUNK
    R = SSD_HEADS // SSD_GROUPS
    x = xs.reshape(Bsz, nc, SSD_CHUNK, SSD_GROUPS, R, SSD_HEAD_DIM)
    dtc = dt.reshape(Bsz, nc, SSD_CHUNK, SSD_GROUPS, R)
    Bc = Bm.reshape(Bsz, nc, SSD_CHUNK, SSD_GROUPS, SSD_STATE)
    Cc = Cm.reshape(Bsz, nc, SSD_CHUNK, SSD_GROUPS, SSD_STATE)
    a_cum = jnp.cumsum(dtc * A.reshape(SSD_GROUPS, R), axis=2)
    xdt = x * dtc[..., None]
    seg = a_cum[:, :, :, None] - a_cum[:, :, None, :]
    causal = jnp.tril(jnp.ones((SSD_CHUNK, SSD_CHUNK), dtype=bool))[:, :, None, None]
    Lmat = jnp.exp(jnp.where(causal, seg, -jnp.inf))
    cb = jnp.einsum('bclgn,bcsgn->bclsg', Cc, Bc)
    y_diag = jnp.einsum('bclsg,bclsgr,bcsgrp->bclgrp', cb, Lmat, xdt)
    decay_to_end = jnp.exp(a_cum[:, :, -1:] - a_cum)
    chunk_states = jnp.einsum('bclgn,bclgr,bclgrp->bcgrpn', Bc, decay_to_end, xdt)
    chunk_decay = jnp.exp(a_cum[:, :, -1])

    def step(h, inp):
        dec, st = inp
        return dec[..., None, None] * h + st, h

    h0 = jnp.zeros((Bsz, SSD_GROUPS, R, SSD_HEAD_DIM, SSD_STATE), jnp.float32)
    _, h_in = lax.scan(step, h0, (jnp.moveaxis(chunk_decay, 1, 0), jnp.moveaxis(chunk_states, 1, 0)))
    h_in = jnp.moveaxis(h_in, 0, 1)
    y_off = jnp.einsum('bclgn,bcgrpn,bclgr->bclgrp', Cc, h_in, jnp.exp(a_cum))
    return (y_diag + y_off).reshape(Bsz, S, SSD_WIDTH)


def gated_rmsnorm(y, z, w):
    yf = y.astype(jnp.float32) * jax.nn.silu(z.astype(jnp.float32))
    yg = yf.reshape(yf.shape[:-1] + (SSD_GROUPS, SSD_WIDTH // SSD_GROUPS))
    yg = yg * lax.rsqrt(jnp.mean(jnp.square(yg), -1, keepdims=True) + LN_EPS)
    return yg.reshape(yf.shape) * w.astype(jnp.float32)


def hybrid_mixer(h, cos, sin, w_in, conv_w, conv_b, dt_bias, a_log, d_skip, ssd_norm_w, sinks, w_out):
    B, S, _ = h.shape
    proj = h @ w_in
    q, k, v, z, xbc, dt_raw = jnp.split(proj, [OFF_Q, OFF_K, OFF_V, OFF_Z, OFF_XBC], axis=-1)
    G = ATT_HEADS // ATT_KV_HEADS
    q = q.reshape(B, S, ATT_KV_HEADS, G, HEAD_DIM)
    k = k.reshape(B, S, ATT_KV_HEADS, HEAD_DIM)
    v = v.reshape(B, S, ATT_KV_HEADS, HEAD_DIM)
    q = apply_partial_rope(q, cos[:, :, None, None, :], sin[:, :, None, None, :])
    k = apply_partial_rope(k, cos[:, :, None, :], sin[:, :, None, :])
    y_att = sliding_window_attention(q, k, v, sinks)
    xbc = jax.nn.silu(causal_depthwise_conv(xbc, conv_w, conv_b))
    xs, Bm, Cm = jnp.split(xbc, [SSD_WIDTH, SSD_WIDTH + SSD_GROUPS * SSD_STATE], axis=-1)
    dt = jax.nn.softplus(dt_raw.astype(jnp.float32) + dt_bias.astype(jnp.float32))
    A = -jnp.exp(a_log.astype(jnp.float32))
    xs4 = xs.astype(jnp.float32).reshape(B, S, SSD_HEADS, SSD_HEAD_DIM)
    y = ssd_chunked(xs4, dt, A,
                    Bm.astype(jnp.float32).reshape(B, S, SSD_GROUPS, SSD_STATE),
                    Cm.astype(jnp.float32).reshape(B, S, SSD_GROUPS, SSD_STATE))
    y = y + (xs4 * d_skip.astype(jnp.float32)[:, None]).reshape(B, S, SSD_WIDTH)
    y_ssd = gated_rmsnorm(y, z, ssd_norm_w).astype(h.dtype)
    return jnp.concatenate([y_att.astype(h.dtype), y_ssd], axis=-1) @ w_out


def peer_ffn(h, w_q, sub_keys1, sub_keys2, u_tab, v_tab):
    B, S, D = h.shape
    half = PEER_KEY_DIM // 2
    q = jnp.einsum('bsd,dhk->bshk', h, w_q).astype(jnp.float32)
    s1 = jnp.einsum('bshk,nk->bshn', q[..., :half], sub_keys1.astype(jnp.float32))
    s2 = jnp.einsum('bshk,nk->bshn', q[..., half:], sub_keys2.astype(jnp.float32))
    v1, i1 = lax.top_k(s1, PEER_TOPK)
    v2, i2 = lax.top_k(s2, PEER_TOPK)
    cand = (v1[..., :, None] + v2[..., None, :]).reshape(B, S, PEER_HEADS, PEER_TOPK * PEER_TOPK)
    cand_id = (i1[..., :, None] * N_KEYS + i2[..., None, :]).reshape(B, S, PEER_HEADS, PEER_TOPK * PEER_TOPK)
    top_s, pos = lax.top_k(cand, PEER_TOPK)
    ids = jnp.take_along_axis(cand_id, pos, axis=-1)
    g = jax.nn.softmax(top_s, axis=-1)
    nblk = (B * S) // PEER_BLOCK
    hb = h.reshape(nblk, PEER_BLOCK, D)
    ib = ids.reshape(nblk, PEER_BLOCK, PEER_HEADS * PEER_TOPK)
    gb = g.astype(h.dtype).reshape(nblk, PEER_BLOCK, PEER_HEADS * PEER_TOPK)

    def block(args):
        hx, ix, gx = args
        u = jnp.take(u_tab, ix, axis=0)
        act = jax.nn.gelu(jnp.einsum('td,tkd->tk', hx, u), approximate=False)
        vv = jnp.take(v_tab, ix, axis=0)
        return jnp.einsum('tk,tkd->td', gx * act, vv)

    out = lax.map(block, (hb, ib, gb))
    return out.reshape(B, S, D)


def setup_inputs(seed: int = 0) -> dict:
    key = jax.random.key(seed)
    ks = jax.random.split(key, 24)
    f32 = jnp.float32
    nrm = lambda k, shape, s: jax.random.normal(k, shape, f32) * s
    half = PEER_KEY_DIM // 2
    dt0 = jnp.exp(jax.random.uniform(ks[7], (DEPTH, SSD_HEADS), f32, math.log(1e-3), math.log(1e-1)))
    dt_bias = dt0 + jnp.log(-jnp.expm1(-dt0))
    return {
        "x": nrm(ks[0], (BATCH, SEQ, D_MODEL), 1.0),
        "c": nrm(ks[1], (BATCH, D_MODEL), 1.0),
        "positions": jnp.broadcast_to(jnp.arange(SEQ, dtype=jnp.int32), (BATCH, SEQ)),
        "w_ada": nrm(ks[2], (DEPTH, D_MODEL, N_MOD * D_MODEL), 0.1 * D_MODEL ** -0.5),
        "b_ada": nrm(ks[3], (DEPTH, N_MOD * D_MODEL), 0.01),
        "w_in": nrm(ks[4], (DEPTH, D_MODEL, IN_WIDTH), D_MODEL ** -0.5),
        "conv_w": nrm(ks[5], (DEPTH, CONV_WIDTH, XBC_WIDTH), CONV_WIDTH ** -0.5),
        "conv_b": nrm(ks[6], (DEPTH, XBC_WIDTH), 0.01),
        "dt_bias": dt_bias,
        "a_log": jnp.log(jax.random.uniform(ks[8], (DEPTH, SSD_HEADS), f32, 1.0, 16.0)),
        "d_skip": 1.0 + nrm(ks[9], (DEPTH, SSD_HEADS), 0.01),
        "ssd_norm_w": 1.0 + nrm(ks[10], (DEPTH, SSD_WIDTH), 0.01),
        "attn_sinks": nrm(ks[11], (DEPTH, ATT_HEADS), 0.5),
        "w_out": nrm(ks[12], (DEPTH, MIX_WIDTH, D_MODEL), BETA * MIX_WIDTH ** -0.5),
        "ln1_g": 1.0 + nrm(ks[13], (DEPTH, D_MODEL), 0.01),
        "ln1_b": nrm(ks[14], (DEPTH, D_MODEL), 0.01),
        "peer_wq": nrm(ks[15], (DEPTH, D_MODEL, PEER_HEADS, PEER_KEY_DIM), D_MODEL ** -0.5),
        "peer_k1": nrm(ks[16], (DEPTH, N_KEYS, half), half ** -0.5),
        "peer_k2": nrm(ks[17], (DEPTH, N_KEYS, half), half ** -0.5),
        "peer_u": nrm(ks[18], (DEPTH, N_EXPERTS, D_MODEL), D_MODEL ** -0.5),
        "peer_v": nrm(ks[19], (DEPTH, N_EXPERTS, D_MODEL), BETA),
        "ln2_g": 1.0 + nrm(ks[20], (DEPTH, D_MODEL), 0.01),
        "ln2_b": nrm(ks[21], (DEPTH, D_MODEL), 0.01),
    }


def reference(x, c, positions, w_ada, b_ada, w_in, conv_w, conv_b, dt_bias, a_log, d_skip,
              ssd_norm_w, attn_sinks, w_out, ln1_g, ln1_b, peer_wq, peer_k1, peer_k2,
              peer_u, peer_v, ln2_g, ln2_b):
    cos, sin = rope_tables(positions)
    c_act = jax.nn.silu(c)
    for l in range(DEPTH):
        mod = (c_act @ w_ada[l] + b_ada[l])[:, None, :]
        sh1, sc1, g1, sh2, sc2, g2 = jnp.split(mod, N_MOD, axis=-1)
        h = x * (1.0 + sc1) + sh1
        mix = hybrid_mixer(h, cos, sin, w_in[l], conv_w[l], conv_b[l], dt_bias[l], a_log[l],
                           d_skip[l], ssd_norm_w[l], attn_sinks[l], w_out[l])
        x = layer_norm(ALPHA * x + (1.0 + g1) * mix, ln1_g[l], ln1_b[l])
        h = x * (1.0 + sc2) + sh2
        ffn = peer_ffn(h, peer_wq[l], peer_k1[l], peer_k2[l], peer_u[l], peer_v[l])
        x = layer_norm(ALPHA * x + (1.0 + g2) * ffn, ln2_g[l], ln2_b[l])
    return x
```

```cpp
#include <hip/hip_runtime.h>
#include <cstdio>
#include <cstdint>

#ifndef MK_N_LAUNCHES
#define MK_N_LAUNCHES 1
#endif

#define LAS __attribute__((address_space(3)))
#define GAS __attribute__((address_space(1)))
typedef unsigned short bf16_t;
typedef short bf16x8 __attribute__((ext_vector_type(8)));
typedef float f32x4 __attribute__((ext_vector_type(4)));
typedef float f32x2 __attribute__((ext_vector_type(2)));
typedef unsigned u32x4 __attribute__((ext_vector_type(4)));
typedef unsigned u32x2 __attribute__((ext_vector_type(2)));

constexpr int S = 8192, D = 2048, NIN = 3856, NINP = 4096;
constexpr int NPH = 12;
constexpr float ALPHA = 1.189207115002721f;
constexpr float LN_EPS = 1e-5f;

constexpr size_t MiB = 1u << 20;
constexpr size_t WS_CTL = 0, CTL_ZERO_BYTES = 64 * 1024;
constexpr size_t WS_MODP = 1 * MiB;
constexpr size_t WS_MOD = 3 * MiB;
constexpr size_t WS_ROPE = 3 * MiB + 512 * 1024;
constexpr size_t WS_WIN = 4 * MiB;
constexpr size_t WS_WOUT = 20 * MiB;
constexpr size_t WS_WSC = 28 * MiB;
constexpr size_t WS_H = 36 * MiB;
constexpr size_t WS_PROJ = 68 * MiB;
constexpr size_t WS_DT = 132 * MiB;
constexpr size_t WS_ACUM = 132 * MiB + 512 * 1024;
constexpr size_t WS_XS = 133 * MiB;
constexpr size_t WS_CPOST = 149 * MiB;
constexpr size_t WS_YDIAG = 153 * MiB;
constexpr size_t WS_STATE = 185 * MiB;
constexpr size_t WS_HIN = 217 * MiB;
constexpr size_t WS_MIXIN = 233 * MiB;
constexpr size_t WS_PRE1 = 265 * MiB;
constexpr size_t WS_IDS = 329 * MiB;
constexpr size_t WS_GATE = 333 * MiB;
constexpr size_t WS_UT = 340 * MiB;
constexpr size_t WS_VT = 404 * MiB;
constexpr size_t WS_END = 468 * MiB;

constexpr int LDS_BYTES = 147456;

__device__ __forceinline__ unsigned cvt_pk_bf16(float lo, float hi) { unsigned r; asm volatile("v_cvt_pk_bf16_f32 %0, %1, %2" : "=v"(r) : "v"(lo), "v"(hi)); return r; }
__device__ __forceinline__ float bf_lo(unsigned u) { return __uint_as_float(u << 16); }
__device__ __forceinline__ float bf_hi(unsigned u) { return __uint_as_float(u & 0xffff0000u); }
__device__ __forceinline__ bf16_t f2bf(float f) { return (bf16_t)(cvt_pk_bf16(f, 0.f) & 0xffffu); }
__device__ __forceinline__ float wave_sum(float v) {
#pragma unroll
    for (int o = 1; o < 64; o <<= 1) v += __shfl_xor(v, o);
    return v;
}
__device__ __forceinline__ float wave_max(float v) {
#pragma unroll
    for (int o = 1; o < 64; o <<= 1) v = fmaxf(v, __shfl_xor(v, o));
    return v;
}
__device__ __forceinline__ float wave_min(float v) {
#pragma unroll
    for (int o = 1; o < 64; o <<= 1) v = fminf(v, __shfl_xor(v, o));
    return v;
}
__device__ __forceinline__ float silu_f(float v) { return v / (1.f + __expf(-v)); }
__device__ __forceinline__ float softplus_f(float v) { return v > 20.f ? v : log1pf(__expf(v)); }
__device__ __forceinline__ float gelu_erf(float v) { return 0.5f * v * (1.f + erff(v * 0.70710678118654752f)); }

namespace pg8 {
constexpr int BM = 256, BK = 64, HALF = 128, HTB = HALF * BK * 2, STAGE_BYTES = 8 * HTB, NXCD = 8, WGM = 8;
__host__ __device__ __forceinline__ int lds_byte(int r, int c) { const int st = (r >> 4) * 2 + (c >> 5), rr = r & 15, cc = c & 31, ob = rr * 64 + cc * 2; return st * 1024 + (ob ^ (((ob >> 9) & 1) << 5)); }
__host__ __device__ __forceinline__ void stage_rc(int b, int& R, int& C) { const int st = b / 1024, sb = b % 1024, swz = sb ^ (((sb >> 9) & 1) << 5); R = (st >> 1) * 16 + swz / 64; C = (st & 1) * 32 + (swz % 64) / 2; }
__host__ __device__ __forceinline__ int perm32(int rho) { const int n = rho >> 4, i = rho & 15; return 8 * (i >> 2) + 4 * n + (i & 3); }

struct Unit { int pm, pn; };
struct Gemm { const bf16_t* A; const bf16_t* Bt; int M, N, K; };

struct StaticOrder {
    int nM, nN, nwg, G, c;
    __host__ __device__ void init(int M, int N, int G_, int c_) { nM = M / BM; nN = N / BM; nwg = nM * nN; G = G_; c = c_; }
    __host__ __device__ bool next(int i, Unit& u) const {
        const long L = (long)i * G + c; if (L >= nwg) return false;
        int wgid = (int)L; { const int q = nwg / NXCD, r = nwg % NXCD, xcd = wgid % NXCD, off = wgid / NXCD; wgid = (xcd < r ? xcd * (q + 1) : r * (q + 1) + (xcd - r) * q) + off; }
        const int nig = WGM * nN, gid = wgid / nig, fm = gid * WGM, gsz = (nM - fm) < WGM ? (nM - fm) : WGM;
        u.pm = fm + ((wgid % nig) % gsz); u.pn = (wgid % nig) / gsz; return true;
    }
    __device__ __forceinline__ void a_ready(const Unit&) const {}
    __device__ __forceinline__ void done(const Unit&) const {}
};

struct EpiProj {
    static constexpr bool PERM = true, AFTER_DRAIN = false;
    bf16_t* O; float* DT; const float* dt_bias;
    __device__ __forceinline__ void operator()(const f32x4 (&acc)[2][2][4][2], const Unit& u, int wr, int wc, int fr, int fq) const {
        const int row0 = u.pm * BM + wr * 64 + fr; const int col0 = u.pn * BM + wc * 32 + 8 * fq;
#pragma unroll
        for (int ai = 0; ai < 2; ++ai)
#pragma unroll
            for (int m = 0; m < 4; ++m) { bf16_t* rowp = O + (size_t)(row0 + ai * HALF + m * 16) * NINP + col0;
#pragma unroll
                for (int bj = 0; bj < 2; ++bj) { const f32x4 v0 = acc[ai][bj][m][0], v1 = acc[ai][bj][m][1];
                    u32x4 w; w.x = cvt_pk_bf16(v0[0], v0[1]); w.y = cvt_pk_bf16(v0[2], v0[3]); w.z = cvt_pk_bf16(v1[0], v1[1]); w.w = cvt_pk_bf16(v1[2], v1[3]);
                    *(u32x4*)(rowp + bj * HALF) = w; } }
        if (u.pn == 15 && wc == 0 && fq < 2) {
            float bias[8];
#pragma unroll
            for (int i = 0; i < 8; ++i) bias[i] = dt_bias[8 * fq + i];
#pragma unroll
            for (int ai = 0; ai < 2; ++ai)
#pragma unroll
                for (int m = 0; m < 4; ++m) { float* dp = DT + (size_t)(row0 + ai * HALF + m * 16) * 16 + 8 * fq; const f32x4 v0 = acc[ai][0][m][0], v1 = acc[ai][0][m][1];
                    f32x4 o0, o1;
#pragma unroll
                    for (int i = 0; i < 4; ++i) { o0[i] = softplus_f(v0[i] + bias[i]); o1[i] = softplus_f(v1[i] + bias[4 + i]); }
                    *(f32x4*)dp = o0; *(f32x4*)(dp + 4) = o1; }
        }
    }
};
struct EpiPre1 {
    static constexpr bool PERM = false, AFTER_DRAIN = false;
    const float* X; const float* g1; float* O;
    __device__ __forceinline__ void operator()(const f32x4 (&acc)[2][2][4][2], const Unit& u, int wr, int wc, int fr, int fq) const {
        const int row0 = u.pm * BM + wr * 64 + fr; const int col0 = u.pn * BM + wc * 32 + 4 * fq;
        f32x4 gv[2][2];
#pragma unroll
        for (int bj = 0; bj < 2; ++bj)
#pragma unroll
            for (int n = 0; n < 2; ++n) gv[bj][n] = *(const f32x4*)(g1 + col0 + bj * HALF + n * 16) + 1.0f;
#pragma unroll
        for (int ai = 0; ai < 2; ++ai)
#pragma unroll
            for (int m = 0; m < 4; ++m) { const size_t off = (size_t)(row0 + ai * HALF + m * 16) * D + col0;
#pragma unroll
                for (int bj = 0; bj < 2; ++bj)
#pragma unroll
                    for (int n = 0; n < 2; ++n) { const f32x4 xv = *(const f32x4*)(X + off + bj * HALF + n * 16);
                        *(f32x4*)(O + off + bj * HALF + n * 16) = xv * ALPHA + gv[bj][n] * acc[ai][bj][m][n]; } }
    }
};
struct EpiF32 {
    static constexpr bool PERM = false, AFTER_DRAIN = false;
    float* O; int ldc;
    __device__ __forceinline__ void operator()(const f32x4 (&acc)[2][2][4][2], const Unit& u, int wr, int wc, int fr, int fq) const {
        const int row0 = u.pm * BM + wr * 64 + fr; const int col0 = u.pn * BM + wc * 32 + 4 * fq;
#pragma unroll
        for (int ai = 0; ai < 2; ++ai)
#pragma unroll
            for (int m = 0; m < 4; ++m) { const size_t off = (size_t)(row0 + ai * HALF + m * 16) * ldc + col0;
#pragma unroll
                for (int bj = 0; bj < 2; ++bj)
#pragma unroll
                    for (int n = 0; n < 2; ++n) *(f32x4*)(O + off + bj * HALF + n * 16) = acc[ai][bj][m][n]; }
    }
};

template <class Epi, class Sched, bool ALIGN_EPI = false, bool SP2 = false>
__device__ __forceinline__ void gemm_phase(LAS unsigned char* lds, const Gemm g, const Sched& S, const Epi& E) {
    const int tid = threadIdx.x, wid = __builtin_amdgcn_readfirstlane(tid >> 6), lane = tid & 63, wr = wid >> 2, wc = wid & 3, fr = lane & 15, fq = lane >> 4;
    const int K = g.K, nt = K / BK;
    unsigned voffA[2], voffB[2];
#pragma unroll
    for (int i = 0; i < 2; ++i) { int R, C; stage_rc(tid * 16 + i * 8192, R, C); const int Rb = Epi::PERM ? ((R & ~31) + perm32(R & 31)) : R;
        voffA[i] = (unsigned)(R * K + C) * 2u; voffB[i] = (unsigned)(Rb * K + C) * 2u; }
    const size_t kstep = (size_t)(BK * 2);
    const size_t hstep = (size_t)HALF * K * 2;
    const size_t tstep = 2 * hstep;
    const unsigned ldsw = (unsigned)wid * 1024u;
    const int aoff = lds_byte(wr * 64 + fr, fq * 8), boff = lds_byte(wc * 32 + fr, fq * 8);
#define PG8_SA(b, h) (((b) * 2 + (h)) * HTB)
#define PG8_SB(b, h) ((4 + (b) * 2 + (h)) * HTB)
#define PG8_STAGE(bufoff, gbase, voff) do { _Pragma("unroll") for (int _i = 0; _i < 2; ++_i) \
        __builtin_amdgcn_global_load_lds((const unsigned*)((const char*)(gbase) + (voff)[_i]), (LAS unsigned*)(lds + (bufoff) + ldsw + _i * 8192), 16, 0, 0); } while (0)
#define PG8_LDA(dst, b, h) do { _Pragma("unroll") for (int m = 0; m < 4; ++m) _Pragma("unroll") for (int k = 0; k < 2; ++k) dst[m][k] = *(const LAS bf16x8*)(lds + PG8_SA(b, h) + aoff + m * 2048 + k * 1024); } while (0)
#define PG8_LDB(dst, b, h) do { _Pragma("unroll") for (int n = 0; n < 2; ++n) _Pragma("unroll") for (int k = 0; k < 2; ++k) dst[n][k] = *(const LAS bf16x8*)(lds + PG8_SB(b, h) + boff + n * 2048 + k * 1024); } while (0)
#define PG8_MMA(ai, bj, At, Bt) do { __builtin_amdgcn_s_setprio(1); _Pragma("unroll") for (int m = 0; m < 4; ++m) _Pragma("unroll") for (int n = 0; n < 2; ++n) _Pragma("unroll") for (int k = 0; k < 2; ++k) \
        acc[ai][bj][m][n] = __builtin_amdgcn_mfma_f32_16x16x32_bf16(Bt[n][k], At[m][k], acc[ai][bj][m][n], 0, 0, 0); __builtin_amdgcn_s_setprio(0); } while (0)
#define PG8_WAIT_V(n) asm volatile("s_waitcnt vmcnt(" #n ")" ::: "memory")
#define PG8_WAIT_L(n) asm volatile("s_waitcnt lgkmcnt(" #n ")" ::: "memory")
#define PG8_BAR __builtin_amdgcn_s_barrier()
#define PG8_SCHED __builtin_amdgcn_sched_barrier(0)
    Unit cur, nxt; int ui = 0;
    if (!S.next(0, cur)) return;
    f32x4 acc[2][2][4][2];
#pragma unroll
    for (int a = 0; a < 2; ++a)
#pragma unroll
        for (int b = 0; b < 2; ++b)
#pragma unroll
            for (int m = 0; m < 4; ++m)
#pragma unroll
                for (int n = 0; n < 2; ++n) acc[a][b][m][n] = (f32x4){0.f, 0.f, 0.f, 0.f};
    bf16x8 At[4][2], B0[2][2], B1[2][2];
    const char* cA = (const char*)g.A + (size_t)cur.pm * tstep; const char* cB = (const char*)g.Bt + (size_t)cur.pn * tstep;
    S.a_ready(cur);
    if constexpr (SP2) {
        PG8_STAGE(PG8_SB(0, 0), cB, voffB); PG8_STAGE(PG8_SB(0, 1), cB + hstep, voffB); PG8_STAGE(PG8_SA(0, 0), cA, voffA); PG8_STAGE(PG8_SA(0, 1), cA + hstep, voffA);
        if (wr == 1) PG8_BAR;
        PG8_WAIT_V(2); PG8_BAR;
        PG8_STAGE(PG8_SB(1, 0), cB + kstep, voffB); PG8_STAGE(PG8_SA(1, 0), cA + kstep, voffA); PG8_STAGE(PG8_SB(1, 1), cB + hstep + kstep, voffB);
        PG8_WAIT_V(6); PG8_BAR;
    } else {
        PG8_STAGE(PG8_SB(0, 0), cB, voffB); PG8_STAGE(PG8_SA(0, 0), cA, voffA); PG8_STAGE(PG8_SB(0, 1), cB + hstep, voffB); PG8_STAGE(PG8_SA(0, 1), cA + hstep, voffA);
        if (wr == 1) PG8_BAR;
        PG8_WAIT_V(4); PG8_BAR;
        PG8_STAGE(PG8_SB(1, 0), cB + kstep, voffB); PG8_STAGE(PG8_SA(1, 0), cA + kstep, voffA); PG8_STAGE(PG8_SB(1, 1), cB + hstep + kstep, voffB);
        PG8_WAIT_V(6); PG8_BAR;
    }
    for (;;) {
        const bool has_next = S.next(ui + 1, nxt);
        const char* nA = has_next ? (const char*)g.A + (size_t)nxt.pm * tstep : cA; const char* nB = has_next ? (const char*)g.Bt + (size_t)nxt.pn * tstep : cB;
        for (int t = 0; t < nt; t += 2) {
            const bool last = (t == nt - 2);
            const char* a1 = cA + (size_t)(t + 1) * kstep;
            const char* a2 = last ? nA : cA + (size_t)(t + 2) * kstep; const char* b2 = last ? nB : cB + (size_t)(t + 2) * kstep;
            const char* a3 = a2 + kstep; const char* b3 = b2 + kstep;
            if (last && has_next) S.a_ready(nxt);
            if constexpr (SP2) {
            PG8_LDB(B0, 0, 0); PG8_LDB(B1, 0, 1); PG8_SCHED; PG8_LDA(At, 0, 0); PG8_STAGE(PG8_SA(1, 1), a1 + hstep, voffA);
            PG8_WAIT_V(8); PG8_WAIT_L(0); PG8_BAR; PG8_MMA(0, 0, At, B0); PG8_MMA(0, 1, At, B1); PG8_BAR; PG8_SCHED;
            PG8_LDA(At, 0, 1); PG8_STAGE(PG8_SB(0, 0), b2, voffB); PG8_STAGE(PG8_SB(0, 1), b2 + hstep, voffB); PG8_STAGE(PG8_SA(0, 0), a2, voffA);
            PG8_WAIT_V(8); PG8_WAIT_L(0); PG8_BAR; PG8_MMA(1, 0, At, B0); PG8_MMA(1, 1, At, B1); PG8_BAR; PG8_SCHED;
            PG8_LDB(B0, 1, 0); PG8_LDB(B1, 1, 1); PG8_SCHED; PG8_LDA(At, 1, 0); PG8_STAGE(PG8_SA(0, 1), a2 + hstep, voffA);
            PG8_WAIT_V(8); PG8_WAIT_L(0); PG8_BAR; PG8_MMA(0, 0, At, B0); PG8_MMA(0, 1, At, B1); PG8_BAR; PG8_SCHED;
            PG8_LDA(At, 1, 1); PG8_STAGE(PG8_SB(1, 0), b3, voffB); PG8_STAGE(PG8_SB(1, 1), b3 + hstep, voffB); PG8_STAGE(PG8_SA(1, 0), a3, voffA);
            PG8_WAIT_V(8); PG8_WAIT_L(0); PG8_BAR; PG8_MMA(1, 0, At, B0); PG8_MMA(1, 1, At, B1); PG8_BAR; PG8_SCHED;
            } else {
            PG8_LDB(B0, 0, 0); PG8_SCHED; PG8_LDA(At, 0, 0); PG8_STAGE(PG8_SA(1, 1), a1 + hstep, voffA);
            PG8_WAIT_L(8); PG8_BAR; PG8_WAIT_L(0); PG8_MMA(0, 0, At, B0); PG8_BAR; PG8_SCHED;
            PG8_LDB(B1, 0, 1); PG8_STAGE(PG8_SB(0, 0), b2, voffB);
            PG8_BAR; PG8_WAIT_L(0); PG8_MMA(0, 1, At, B1); PG8_BAR;
            PG8_LDA(At, 0, 1); PG8_STAGE(PG8_SA(0, 0), a2, voffA);
            PG8_BAR; PG8_WAIT_L(0); PG8_MMA(1, 0, At, B0); PG8_BAR; PG8_SCHED;
            PG8_STAGE(PG8_SB(0, 1), b2 + hstep, voffB);
            PG8_WAIT_V(6); PG8_BAR; PG8_MMA(1, 1, At, B1); PG8_BAR;
            PG8_LDB(B0, 1, 0); PG8_SCHED; PG8_LDA(At, 1, 0); PG8_STAGE(PG8_SA(0, 1), a2 + hstep, voffA);
            PG8_WAIT_L(8); PG8_BAR; PG8_WAIT_L(0); PG8_MMA(0, 0, At, B0); PG8_BAR; PG8_SCHED;
            PG8_LDB(B1, 1, 1); PG8_STAGE(PG8_SB(1, 0), b3, voffB);
            PG8_BAR; PG8_WAIT_L(0); PG8_MMA(0, 1, At, B1); PG8_BAR;
            PG8_LDA(At, 1, 1); PG8_STAGE(PG8_SA(1, 0), a3, voffA);
            PG8_BAR; PG8_WAIT_L(0); PG8_MMA(1, 0, At, B0); PG8_BAR; PG8_SCHED;
            PG8_STAGE(PG8_SB(1, 1), b3 + hstep, voffB);
            PG8_WAIT_V(6); PG8_BAR; PG8_MMA(1, 1, At, B1); PG8_BAR;
            }
        }
        if constexpr (ALIGN_EPI) { if (wr == 0) PG8_BAR; }
        if constexpr (!Epi::AFTER_DRAIN) { E(acc, cur, wr, wc, fr, fq); S.done(cur); }
        if (!has_next) break;
#pragma unroll
        for (int a = 0; a < 2; ++a)
#pragma unroll
            for (int b = 0; b < 2; ++b)
#pragma unroll
                for (int m = 0; m < 4; ++m)
#pragma unroll
                    for (int n = 0; n < 2; ++n) acc[a][b][m][n] = (f32x4){0.f, 0.f, 0.f, 0.f};
        cur = nxt; cA = nA; cB = nB; ++ui;
        if constexpr (ALIGN_EPI) { if (wr == 1) PG8_BAR; }
    }
    PG8_WAIT_V(0);
    if constexpr (!ALIGN_EPI) { if (wr == 0) PG8_BAR; }
    PG8_BAR;
#undef PG8_SA
#undef PG8_SB
#undef PG8_STAGE
#undef PG8_LDA
#undef PG8_LDB
#undef PG8_MMA
#undef PG8_WAIT_V
#undef PG8_WAIT_L
#undef PG8_BAR
#undef PG8_SCHED
}
}

typedef GAS unsigned gu32;
#define XB_TMO      128
#define XB_XCNT(j)  (256  + 64 * (j))
#define XB_XSUB(j)  (1280 + 64 * (j))
#define XB_XGEN(j)  (2304 + 64 * (j))
#define XB_TOP      3328
#define XB_TOPGEN   3392
#define XCD_BAR_WORDS 3456
#define XB_SPIN_CAP (1u << 22)
__device__ __forceinline__ unsigned xb_ld(unsigned* p)              { return __hip_atomic_load(p, __ATOMIC_RELAXED, __HIP_MEMORY_SCOPE_AGENT); }
__device__ __forceinline__ unsigned xb_add(unsigned* p, unsigned v) { return __hip_atomic_fetch_add(p, v, __ATOMIC_RELAXED, __HIP_MEMORY_SCOPE_AGENT); }
__device__ __forceinline__ unsigned xb_xcc_id() { return (unsigned)__builtin_amdgcn_s_getreg((3 << 11) | 20) & 0xFu; }
#define XB_SPIN(cond, bar) do { unsigned _sp = 0; while (cond) { __builtin_amdgcn_s_sleep(1); \
    if ((++_sp & 255u) == 0u) { if (xb_ld(&(bar)[XB_TMO])) break; if (_sp > XB_SPIN_CAP) { atomicAdd(&(bar)[XB_TMO], 1u); break; } } } } while (0)
struct XcdBarrier { unsigned* bar; unsigned x; volatile LAS unsigned* st; };
__device__ __forceinline__ XcdBarrier xcd_barrier_post(unsigned* bar, volatile LAS unsigned* st) {
    XcdBarrier b; b.bar = bar; b.x = xb_xcc_id(); b.st = st;
    if (threadIdx.x == 0) (void)xb_add(&bar[XB_XCNT(b.x)], 1u);
    return b;
}
__device__ __forceinline__ void xcd_barrier_complete(unsigned* bar, unsigned x, unsigned& nloc, unsigned& nx) {
    const unsigned G = gridDim.x * gridDim.y * gridDim.z;
    unsigned sum, cnt, mine, sp = 0u;
    for (;;) {
        sum = 0u; cnt = 0u; mine = 0u;
#pragma unroll
        for (unsigned j = 0; j < 16; ++j) { const unsigned c = xb_ld(&bar[XB_XCNT(j)]); sum += c; cnt += (c > 0u) ? 1u : 0u; mine = (j == x) ? c : mine; }
        if (sum == G) break;
        __builtin_amdgcn_s_sleep(1);
        if ((++sp & 255u) == 0u) { if (xb_ld(&bar[XB_TMO])) break; if (sp > XB_SPIN_CAP) { atomicAdd(&bar[XB_TMO], 1u); break; } }
    }
    nloc = mine > 0u ? mine : 1u; nx = cnt > 0u ? cnt : 1u;
}
__device__ __forceinline__ void xcd_barrier(const XcdBarrier& b) {
    asm volatile("s_waitcnt vmcnt(0)" ::: "memory");
    __syncthreads();
    if (threadIdx.x == 0) {
        unsigned* bar = b.bar;
        __builtin_amdgcn_s_waitcnt(0);
        unsigned nloc = b.st[0], nx = b.st[1];
        if (nloc == 0u) { xcd_barrier_complete(bar, b.x, nloc, nx); b.st[0] = nloc; b.st[1] = nx; }
        const unsigned old = xb_add(&bar[XB_XSUB(b.x)], 1u);
        const unsigned gen = old / nloc;
        if (old + 1u == (gen + 1u) * nloc) {
            __builtin_amdgcn_fence(__ATOMIC_RELEASE, "agent");
            asm volatile("s_waitcnt vmcnt(0)" ::: "memory");
            const unsigned og = xb_add(&bar[XB_TOP], 1u);
            const unsigned tg = og / nx;
            if (og + 1u == (tg + 1u) * nx) xb_add(&bar[XB_TOPGEN], 1u);
            else XB_SPIN(xb_ld(&bar[XB_TOPGEN]) == tg, bar);
            __builtin_amdgcn_fence(__ATOMIC_ACQUIRE, "agent");
            xb_add(&bar[XB_XGEN(b.x)], 1u);
            asm volatile("s_waitcnt vmcnt(0)" ::: "memory");
        } else {
            XB_SPIN(xb_ld(&bar[XB_XGEN(b.x)]) == gen, bar);
            __builtin_amdgcn_fence(__ATOMIC_ACQUIRE, "agent");
            asm volatile("s_waitcnt vmcnt(0)" ::: "memory");
        }
    }
    __syncthreads();
}

struct Args { const float* in[23]; float* out; unsigned char* ws; int ph_lo, ph_hi; };
enum { I_X = 0, I_C, I_POS, I_WADA, I_BADA, I_WIN, I_CONVW, I_CONVB, I_DTB, I_ALOG, I_DSKIP, I_NORMW, I_SINK, I_WOUT, I_LN1G, I_LN1B, I_WQ, I_K1, I_K2, I_U, I_V, I_LN2G, I_LN2B };

__device__ __forceinline__ void p0_transpose_item(const float* W, int K, int N, int Npad, bf16_t* WT, LAS float* scr, int item, int lane) {
    const int nblk = Npad / 32, kb = item / nblk, nb = item % nblk, k0 = 64 * kb, n0 = 32 * nb;
    const int ncol = n0 + (lane & 31);
#pragma unroll 8
    for (int i = 0; i < 32; ++i) { const int kk = 2 * i + (lane >> 5); scr[kk * 33 + (lane & 31)] = (ncol < N) ? W[(size_t)(k0 + kk) * N + ncol] : 0.f; }
    asm volatile("s_waitcnt lgkmcnt(0)" ::: "memory");
    const int c = lane & 7;
#pragma unroll
    for (int j = 0; j < 4; ++j) { const int n = (lane >> 3) + 8 * j; const LAS float* s = scr + (8 * c) * 33 + n;
        u32x4 o; o.x = cvt_pk_bf16(s[0 * 33], s[1 * 33]); o.y = cvt_pk_bf16(s[2 * 33], s[3 * 33]); o.z = cvt_pk_bf16(s[4 * 33], s[5 * 33]); o.w = cvt_pk_bf16(s[6 * 33], s[7 * 33]);
        *(u32x4*)(WT + (size_t)(n0 + n) * K + k0 + 8 * c) = o; }
    asm volatile("s_waitcnt lgkmcnt(0)" ::: "memory");
}

__device__ __forceinline__ void phase0(const Args& a, LAS unsigned char* lds, int bid, int nb, int tid) {
    unsigned char* ws = a.ws;
    const int wave = tid >> 6, lane = tid & 63;
    {
        const float* c = a.in[I_C]; const float* w_ada = a.in[I_WADA]; float* modp = (float*)(ws + WS_MODP);
        for (int item = bid; item < 256; item += nb) {
            const int kc = item >> 3, ns = item & 7, k0 = kc * 64, n0 = ns * 1536;
            if (tid < 384) {
                f32x4 acc = {0.f, 0.f, 0.f, 0.f};
                const float* wp = w_ada + (size_t)k0 * 12288 + n0 + tid * 4;
#pragma unroll 8
                for (int k = 0; k < 64; ++k) { const float cv = c[k0 + k]; const float s = cv / (1.f + __expf(-cv)); const f32x4 w = *(const f32x4*)(wp + (size_t)k * 12288); acc += w * s; }
                *(f32x4*)(modp + (size_t)kc * 12288 + n0 + tid * 4) = acc;
            }
        }
    }
    {
        LAS float* scr = (LAS float*)(lds + wave * 16384);
        const int gw = bid * 8 + wave, NGW = nb * 8;
        constexpr int I_IN = (D / 64) * (NINP / 32), I_OUT = (D / 64) * (D / 32);
        for (int it = gw; it < I_IN + I_OUT; it += NGW) {
            if (it < I_IN) p0_transpose_item(a.in[I_WIN], D, NIN, NINP, (bf16_t*)(ws + WS_WIN), scr, it, lane);
            else p0_transpose_item(a.in[I_WOUT], D, D, D, (bf16_t*)(ws + WS_WOUT), scr, it - I_IN, lane);
        }
    }
    __syncthreads();
    {
        LAS float* keyS = (LAS float*)lds;
        LAS float* wqS = keyS + 128 * 65;
        bf16_t* WSC = (bf16_t*)(ws + WS_WSC);
        for (int item = bid; item < 512; item += nb) {
            const int half = item & 1, h = (item >> 1) & 7, db = item >> 4, d0 = db * 64;
            const float* keys = a.in[half ? I_K2 : I_K1];
            const float* wq = a.in[I_WQ];
#pragma unroll
            for (int i = 0; i < 16; ++i) { const int e = tid + i * 512; keyS[(e >> 6) * 65 + (e & 63)] = keys[e]; }
#pragma unroll
            for (int i = 0; i < 8; ++i) { const int e = tid + i * 512; const int dd = e >> 6, k = e & 63; wqS[dd * 65 + k] = wq[(size_t)(d0 + dd) * 1024 + h * 128 + half * 64 + k]; }
            __syncthreads();
            const int dd = tid & 63, ng = tid >> 6;
            float acc[16];
#pragma unroll
            for (int i = 0; i < 16; ++i) acc[i] = 0.f;
            for (int k = 0; k < 64; ++k) { const float wv = wqS[dd * 65 + k];
#pragma unroll
                for (int i = 0; i < 16; ++i) acc[i] += wv * keyS[(ng * 16 + i) * 65 + k]; }
#pragma unroll
            for (int i = 0; i < 16; ++i) WSC[(size_t)(half * 1024 + h * 128 + ng * 16 + i) * D + d0 + dd] = f2bf(acc[i]);
            __syncthreads();
        }
    }
    {
        const size_t nthr = (size_t)nb * 512, gt = (size_t)bid * 512 + tid;
        const size_t n8 = (size_t)16384 * 2048 / 8;
        for (int tbl = 0; tbl < 2; ++tbl) {
            const float* src = a.in[tbl ? I_V : I_U]; bf16_t* dst = (bf16_t*)(ws + (tbl ? WS_VT : WS_UT));
            for (size_t i = gt; i < n8; i += nthr) {
                const f32x4 v0 = *(const f32x4*)(src + i * 8), v1 = *(const f32x4*)(src + i * 8 + 4);
                u32x4 o; o.x = cvt_pk_bf16(v0[0], v0[1]); o.y = cvt_pk_bf16(v0[2], v0[3]); o.z = cvt_pk_bf16(v1[0], v1[1]); o.w = cvt_pk_bf16(v1[2], v1[3]);
                *(u32x4*)(dst + i * 8) = o;
            }
        }
    }
    {
        const int* pos = (const int*)a.in[I_POS]; f32x2* rope = (f32x2*)(ws + WS_ROPE);
        for (int e = bid * 512 + tid; e < S * 8; e += nb * 512) {
            const int t = e >> 3, i = e & 7;
            const float invs[8] = {1.0f, 0.19392274474868576f, 0.03760603093086393f, 0.007292664737217109f, 0.001414213562373095f, 0.0002742481756762073f, 5.318295896944988e-05f, 1.031338537721246e-05f};
            float inv = invs[0];
#pragma unroll
            for (int j = 1; j < 8; ++j) inv = (i == j) ? invs[j] : inv;
            const float ang = (float)pos[t] * inv;
            float sn, cs; sincosf(ang, &sn, &cs);
            rope[e] = (f32x2){cs, sn};
        }
    }
}

__device__ __forceinline__ void phase1(const Args& a, int bid, int nb, int tid) {
    const float* modp = (const float*)(a.ws + WS_MODP); float* mod = (float*)(a.ws + WS_MOD); const float* b_ada = a.in[I_BADA];
    for (int n = bid * 512 + tid; n < 12288; n += nb * 512) { float s = b_ada[n];
#pragma unroll 8
        for (int k = 0; k < 32; ++k) s += modp[(size_t)k * 12288 + n];
        mod[n] = s; }
}

__device__ __forceinline__ void phase2(const Args& a, int bid, int nb, int tid) {
    const float* x = a.in[I_X]; const float* mod = (const float*)(a.ws + WS_MOD); bf16_t* H = (bf16_t*)(a.ws + WS_H);
    const size_t n8 = (size_t)S * D / 8, nthr = (size_t)nb * 512;
    for (size_t i = (size_t)bid * 512 + tid; i < n8; i += nthr) {
        const int col = (int)((i * 8) & (D - 1));
        const f32x4 v0 = *(const f32x4*)(x + i * 8), v1 = *(const f32x4*)(x + i * 8 + 4);
        const f32x4 sh0 = *(const f32x4*)(mod + col), sh1 = *(const f32x4*)(mod + col + 4), sc0 = *(const f32x4*)(mod + D + col), sc1 = *(const f32x4*)(mod + D + col + 4);
        const f32x4 h0 = v0 * (sc0 + 1.0f) + sh0, h1 = v1 * (sc1 + 1.0f) + sh1;
        u32x4 o; o.x = cvt_pk_bf16(h0[0], h0[1]); o.y = cvt_pk_bf16(h0[2], h0[3]); o.z = cvt_pk_bf16(h1[0], h1[1]); o.w = cvt_pk_bf16(h1[2], h1[3]);
        *(u32x4*)(H + i * 8) = o;
    }
}

__device__ __forceinline__ void rope16(u32x4& a, u32x4& b, const f32x2* rp) {
    float t1[8], t2[8];
    t1[0] = bf_lo(a.x); t1[1] = bf_hi(a.x); t1[2] = bf_lo(a.y); t1[3] = bf_hi(a.y); t1[4] = bf_lo(a.z); t1[5] = bf_hi(a.z); t1[6] = bf_lo(a.w); t1[7] = bf_hi(a.w);
    t2[0] = bf_lo(b.x); t2[1] = bf_hi(b.x); t2[2] = bf_lo(b.y); t2[3] = bf_hi(b.y); t2[4] = bf_lo(b.z); t2[5] = bf_hi(b.z); t2[6] = bf_lo(b.w); t2[7] = bf_hi(b.w);
    float o1[8], o2[8];
#pragma unroll
    for (int i = 0; i < 8; ++i) { const f32x2 cs = rp[i]; o1[i] = t1[i] * cs.x - t2[i] * cs.y; o2[i] = t2[i] * cs.x + t1[i] * cs.y; }
    a.x = cvt_pk_bf16(o1[0], o1[1]); a.y = cvt_pk_bf16(o1[2], o1[3]); a.z = cvt_pk_bf16(o1[4], o1[5]); a.w = cvt_pk_bf16(o1[6], o1[7]);
    b.x = cvt_pk_bf16(o2[0], o2[1]); b.y = cvt_pk_bf16(o2[2], o2[3]); b.z = cvt_pk_bf16(o2[4], o2[5]); b.w = cvt_pk_bf16(o2[6], o2[7]);
}

__device__ __forceinline__ void attn_item(const Args& a, LAS unsigned char* lds, int qb, int hd, int tid) {
    const bf16_t* PROJ = (const bf16_t*)(a.ws + WS_PROJ); const f32x2* ROPE = (const f32x2*)(a.ws + WS_ROPE); bf16_t* MIXIN = (bf16_t*)(a.ws + WS_MIXIN);
    LAS bf16_t* Ks = (LAS bf16_t*)lds;
    LAS bf16_t* Qs = Ks + 256 * 72;
    LAS bf16_t* Vt = Qs + 128 * 72;
    const int kvh = hd >> 3, t0 = qb * 128;
    {
        const int row = tid >> 2, q4 = tid & 3, tok = t0 + row;
        const bf16_t* src = PROJ + (size_t)tok * NINP + hd * 64 + q4 * 16;
        u32x4 x0 = *(const u32x4*)src, x1 = *(const u32x4*)(src + 8);
        if (q4 == 0) rope16(x0, x1, ROPE + tok * 8);
        *(LAS u32x4*)(Qs + row * 72 + q4 * 16) = x0; *(LAS u32x4*)(Qs + row * 72 + q4 * 16 + 8) = x1;
    }
#pragma unroll
    for (int i = 0; i < 2; ++i) {
        const int idx = tid + i * 512, row = idx >> 2, q4 = idx & 3, tok = t0 - 128 + row;
        u32x4 x0 = {0u, 0u, 0u, 0u}, x1 = {0u, 0u, 0u, 0u};
        if (tok >= 0) { const bf16_t* src = PROJ + (size_t)tok * NINP + 1024 + kvh * 64 + q4 * 16; x0 = *(const u32x4*)src; x1 = *(const u32x4*)(src + 8); if (q4 == 0) rope16(x0, x1, ROPE + tok * 8); }
        *(LAS u32x4*)(Ks + row * 72 + q4 * 16) = x0; *(LAS u32x4*)(Ks + row * 72 + q4 * 16 + 8) = x1;
    }
#pragma unroll
    for (int i = 0; i < 4; ++i) {
        const int idx = tid + i * 512, key = idx >> 3, ch = idx & 7, tok = t0 - 128 + key;
        u32x4 v = {0u, 0u, 0u, 0u};
        if (tok >= 0) v = *(const u32x4*)(PROJ + (size_t)tok * NINP + 1152 + kvh * 64 + ch * 8);
        LAS bf16_t* dst = Vt + (ch * 8) * 264 + key;
        dst[0 * 264] = (bf16_t)(v.x & 0xffffu); dst[1 * 264] = (bf16_t)(v.x >> 16); dst[2 * 264] = (bf16_t)(v.y & 0xffffu); dst[3 * 264] = (bf16_t)(v.y >> 16);
        dst[4 * 264] = (bf16_t)(v.z & 0xffffu); dst[5 * 264] = (bf16_t)(v.z >> 16); dst[6 * 264] = (bf16_t)(v.w & 0xffffu); dst[7 * 264] = (bf16_t)(v.w >> 16);
    }
    __syncthreads();
    const int w = tid >> 6, lane = tid & 63, fr = lane & 15, kq = lane >> 4;
    bf16x8 qf[2];
#pragma unroll
    for (int ks = 0; ks < 2; ++ks) qf[ks] = *(const LAS bf16x8*)(Qs + (16 * w + fr) * 72 + 32 * ks + 8 * kq);
    f32x4 s[16];
#pragma unroll
    for (int t = 0; t < 16; ++t) { s[t] = (f32x4){0.f, 0.f, 0.f, 0.f};
#pragma unroll
        for (int ks = 0; ks < 2; ++ks) { const bf16x8 kf = *(const LAS bf16x8*)(Ks + (16 * t + fr) * 72 + 32 * ks + 8 * kq); s[t] = __builtin_amdgcn_mfma_f32_16x16x32_bf16(kf, qf[ks], s[t], 0, 0, 0); } }
    const float sink = a.in[I_SINK][hd];
    const int qi = 16 * w + fr;
    float mx = sink;
#pragma unroll
    for (int t = 0; t < 16; ++t)
#pragma unroll
        for (int r = 0; r < 4; ++r) { const int j = 16 * t + 4 * kq + r; const bool valid = (j > qi) && (j <= qi + 128) && (qb > 0 || j >= 128);
            const float v = valid ? s[t][r] * 0.125f : -INFINITY; s[t][r] = v; mx = fmaxf(mx, v); }
    mx = fmaxf(mx, __shfl_xor(mx, 16)); mx = fmaxf(mx, __shfl_xor(mx, 32));
    float sum = 0.f;
#pragma unroll
    for (int t = 0; t < 16; ++t)
#pragma unroll
        for (int r = 0; r < 4; ++r) { const float p = __expf(s[t][r] - mx); s[t][r] = p; sum += p; }
    sum += __shfl_xor(sum, 16); sum += __shfl_xor(sum, 32);
    const float inv = 1.f / (sum + __expf(sink - mx));
    f32x4 o[4];
#pragma unroll
    for (int dt = 0; dt < 4; ++dt) o[dt] = (f32x4){0.f, 0.f, 0.f, 0.f};
#pragma unroll
    for (int u = 0; u < 8; ++u) {
        u32x4 pw; pw.x = cvt_pk_bf16(s[2 * u][0] * inv, s[2 * u][1] * inv); pw.y = cvt_pk_bf16(s[2 * u][2] * inv, s[2 * u][3] * inv);
        pw.z = cvt_pk_bf16(s[2 * u + 1][0] * inv, s[2 * u + 1][1] * inv); pw.w = cvt_pk_bf16(s[2 * u + 1][2] * inv, s[2 * u + 1][3] * inv);
        const bf16x8 pf = __builtin_bit_cast(bf16x8, pw);
#pragma unroll
        for (int dt = 0; dt < 4; ++dt) { const LAS bf16_t* vp = Vt + (16 * dt + fr) * 264 + 32 * u + 4 * kq;
            const u32x2 lo = *(const LAS u32x2*)vp, hi = *(const LAS u32x2*)(vp + 16);
            const u32x4 vw = {lo.x, lo.y, hi.x, hi.y};
            o[dt] = __builtin_amdgcn_mfma_f32_16x16x32_bf16(pf, __builtin_bit_cast(bf16x8, vw), o[dt], 0, 0, 0); }
    }
#pragma unroll
    for (int dt = 0; dt < 4; ++dt)
#pragma unroll
        for (int r = 0; r < 4; ++r) MIXIN[(size_t)(t0 + 16 * w + 4 * kq + r) * D + hd * 64 + 16 * dt + fr] = f2bf(o[dt][r]);
    __syncthreads();
}

__device__ __forceinline__ void ssda_item(const Args& a, LAS unsigned char* lds, int c, int h, int tid) {
    unsigned char* ws = a.ws;
    const bf16_t* PROJ = (const bf16_t*)(ws + WS_PROJ); const float* DT = (const float*)(ws + WS_DT); float* ACUM = (float*)(ws + WS_ACUM);
    bf16_t* XS = (bf16_t*)(ws + WS_XS); bf16_t* CPOST = (bf16_t*)(ws + WS_CPOST); float* YDIAG = (float*)(ws + WS_YDIAG); float* STATE = (float*)(ws + WS_STATE);
    LAS bf16_t* Bs = (LAS bf16_t*)lds;
    LAS bf16_t* BT = Bs + 128 * 136;
    LAS bf16_t* Cs = BT + 128 * 136;
    LAS bf16_t* XT = Cs + 128 * 136;
    LAS bf16_t* XDT = XT + 64 * 136;
    LAS float* dtS = (LAS float*)(XDT + 64 * 136);
    LAS float* acS = dtS + 128;
    const int g = h >> 3, tok0 = c * 128;
    const int w = tid >> 6, lane = tid & 63, fr = lane & 15, kq = lane >> 4;
    if (w == 0) {
        const float d0 = DT[(size_t)(tok0 + 2 * lane) * 16 + h], d1 = DT[(size_t)(tok0 + 2 * lane + 1) * 16 + h];
        const float A = -__expf(a.in[I_ALOG][h]);
        const float a0 = d0 * A, a1 = d1 * A;
        float sc = a0 + a1;
#pragma unroll
        for (int off = 1; off < 64; off <<= 1) { const float v = __shfl_up(sc, off); if (lane >= off) sc += v; }
        dtS[2 * lane] = d0; dtS[2 * lane + 1] = d1; acS[2 * lane] = sc - a1; acS[2 * lane + 1] = sc;
        ACUM[(size_t)(tok0 + 2 * lane) * 16 + h] = sc - a1; ACUM[(size_t)(tok0 + 2 * lane + 1) * 16 + h] = sc;
    }
    __syncthreads();
    const float acEnd = acS[127];
    const float* convw = a.in[I_CONVW]; const float* convb = a.in[I_CONVB];
    for (int i = 0; i < 5; ++i) {
        const int idx = tid + i * 512, cp = idx % 160, tg = idx / 160, ci = cp * 2;
        int xch; if (ci < 64) xch = h * 64 + ci; else if (ci < 192) xch = 1024 + g * 128 + (ci - 64); else xch = 1280 + g * 128 + (ci - 192);
        float w0[4], w1[4];
#pragma unroll
        for (int q = 0; q < 4; ++q) { w0[q] = convw[q * 1536 + xch]; w1[q] = convw[q * 1536 + xch + 1]; }
        const float b0 = convb[xch], b1 = convb[xch + 1];
        float r0[11], r1[11];
#pragma unroll
        for (int r = 0; r < 11; ++r) { const int tok = tok0 + tg * 8 - 3 + r; unsigned u = 0u; if (tok >= 0) u = *(const unsigned*)(PROJ + (size_t)tok * NINP + 2304 + xch); r0[r] = bf_lo(u); r1[r] = bf_hi(u); }
        float o0[8], o1[8];
#pragma unroll
        for (int j = 0; j < 8; ++j) { float v0 = b0, v1 = b1;
#pragma unroll
            for (int q = 0; q < 4; ++q) { v0 += w0[q] * r0[j + q]; v1 += w1[q] * r1[j + q]; }
            o0[j] = silu_f(v0); o1[j] = silu_f(v1); }
        const int l0 = tg * 8;
        if (ci < 64) {
            float x0[8], x1[8], y0[8], y1[8];
#pragma unroll
            for (int j = 0; j < 8; ++j) { const float dtv = dtS[l0 + j], dec = __expf(acEnd - acS[l0 + j]);
                *(unsigned*)(XS + (size_t)(tok0 + l0 + j) * 1024 + h * 64 + ci) = cvt_pk_bf16(o0[j], o1[j]);
                x0[j] = o0[j] * dtv; x1[j] = o1[j] * dtv; y0[j] = x0[j] * dec; y1[j] = x1[j] * dec; }
            u32x4 p; p.x = cvt_pk_bf16(x0[0], x0[1]); p.y = cvt_pk_bf16(x0[2], x0[3]); p.z = cvt_pk_bf16(x0[4], x0[5]); p.w = cvt_pk_bf16(x0[6], x0[7]); *(LAS u32x4*)(XT + ci * 136 + l0) = p;
            p.x = cvt_pk_bf16(x1[0], x1[1]); p.y = cvt_pk_bf16(x1[2], x1[3]); p.z = cvt_pk_bf16(x1[4], x1[5]); p.w = cvt_pk_bf16(x1[6], x1[7]); *(LAS u32x4*)(XT + (ci + 1) * 136 + l0) = p;
            p.x = cvt_pk_bf16(y0[0], y0[1]); p.y = cvt_pk_bf16(y0[2], y0[3]); p.z = cvt_pk_bf16(y0[4], y0[5]); p.w = cvt_pk_bf16(y0[6], y0[7]); *(LAS u32x4*)(XDT + ci * 136 + l0) = p;
            p.x = cvt_pk_bf16(y1[0], y1[1]); p.y = cvt_pk_bf16(y1[2], y1[3]); p.z = cvt_pk_bf16(y1[4], y1[5]); p.w = cvt_pk_bf16(y1[6], y1[7]); *(LAS u32x4*)(XDT + (ci + 1) * 136 + l0) = p;
        } else if (ci < 192) {
            const int n = ci - 64;
#pragma unroll
            for (int j = 0; j < 8; ++j) *(LAS unsigned*)(Bs + (l0 + j) * 136 + n) = cvt_pk_bf16(o0[j], o1[j]);
            u32x4 p; p.x = cvt_pk_bf16(o0[0], o0[1]); p.y = cvt_pk_bf16(o0[2], o0[3]); p.z = cvt_pk_bf16(o0[4], o0[5]); p.w = cvt_pk_bf16(o0[6], o0[7]); *(LAS u32x4*)(BT + n * 136 + l0) = p;
            p.x = cvt_pk_bf16(o1[0], o1[1]); p.y = cvt_pk_bf16(o1[2], o1[3]); p.z = cvt_pk_bf16(o1[4], o1[5]); p.w = cvt_pk_bf16(o1[6], o1[7]); *(LAS u32x4*)(BT + (n + 1) * 136 + l0) = p;
        } else {
            const int n = ci - 192;
#pragma unroll
            for (int j = 0; j < 8; ++j) { const unsigned pk = cvt_pk_bf16(o0[j], o1[j]); *(LAS unsigned*)(Cs + (l0 + j) * 136 + n) = pk;
                if ((h & 7) == 0) *(unsigned*)(CPOST + (size_t)(tok0 + l0 + j) * 256 + g * 128 + n) = pk; }
        }
    }
    __syncthreads();
    bf16x8 cf[4];
#pragma unroll
    for (int ks = 0; ks < 4; ++ks) cf[ks] = *(const LAS bf16x8*)(Cs + (16 * w + fr) * 136 + 32 * ks + 8 * kq);
    f32x4 s[8];
#pragma unroll
    for (int t = 0; t < 8; ++t) { s[t] = (f32x4){0.f, 0.f, 0.f, 0.f};
        if (t <= w) {
#pragma unroll
            for (int ks = 0; ks < 4; ++ks) { const bf16x8 bf = *(const LAS bf16x8*)(Bs + (16 * t + fr) * 136 + 32 * ks + 8 * kq); s[t] = __builtin_amdgcn_mfma_f32_16x16x32_bf16(bf, cf[ks], s[t], 0, 0, 0); } } }
    const int li = 16 * w + fr; const float al = acS[li];
#pragma unroll
    for (int t = 0; t < 8; ++t)
#pragma unroll
        for (int r = 0; r < 4; ++r) { const int si = 16 * t + 4 * kq + r; s[t][r] = (si <= li) ? s[t][r] * __expf(al - acS[si]) : 0.f; }
    f32x4 o[4];
#pragma unroll
    for (int pt = 0; pt < 4; ++pt) o[pt] = (f32x4){0.f, 0.f, 0.f, 0.f};
#pragma unroll
    for (int u = 0; u < 4; ++u) {
        if (2 * u <= w) {
            u32x4 pw; pw.x = cvt_pk_bf16(s[2 * u][0], s[2 * u][1]); pw.y = cvt_pk_bf16(s[2 * u][2], s[2 * u][3]); pw.z = cvt_pk_bf16(s[2 * u + 1][0], s[2 * u + 1][1]); pw.w = cvt_pk_bf16(s[2 * u + 1][2], s[2 * u + 1][3]);
            const bf16x8 pf = __builtin_bit_cast(bf16x8, pw);
#pragma unroll
            for (int pt = 0; pt < 4; ++pt) { const LAS bf16_t* xp = XT + (16 * pt + fr) * 136 + 32 * u + 4 * kq;
                const u32x2 lo = *(const LAS u32x2*)xp, hi = *(const LAS u32x2*)(xp + 16); const u32x4 vw = {lo.x, lo.y, hi.x, hi.y};
                o[pt] = __builtin_amdgcn_mfma_f32_16x16x32_bf16(pf, __builtin_bit_cast(bf16x8, vw), o[pt], 0, 0, 0); }
        }
    }
#pragma unroll
    for (int pt = 0; pt < 4; ++pt)
#pragma unroll
        for (int r = 0; r < 4; ++r) YDIAG[(size_t)(tok0 + 16 * w + 4 * kq + r) * 1024 + h * 64 + 16 * pt + fr] = o[pt][r];
#pragma unroll
    for (int pt = 0; pt < 4; ++pt) {
        f32x4 acc = {0.f, 0.f, 0.f, 0.f};
#pragma unroll
        for (int ks = 0; ks < 4; ++ks) { const bf16x8 af = *(const LAS bf16x8*)(XDT + (16 * pt + fr) * 136 + 32 * ks + 8 * kq); const bf16x8 bf = *(const LAS bf16x8*)(BT + (16 * w + fr) * 136 + 32 * ks + 8 * kq);
            acc = __builtin_amdgcn_mfma_f32_16x16x32_bf16(af, bf, acc, 0, 0, 0); }
#pragma unroll
        for (int r = 0; r < 4; ++r) STATE[((size_t)(c * 16 + h) * 64 + 16 * pt + 4 * kq + r) * 128 + 16 * w + fr] = acc[r];
    }
    __syncthreads();
}

__device__ __forceinline__ void phase5(const Args& a, int bid, int nb, int tid) {
    const float* STATE = (const float*)(a.ws + WS_STATE); const float* ACUM = (const float*)(a.ws + WS_ACUM); bf16_t* HIN = (bf16_t*)(a.ws + WS_HIN);
    for (int e = bid * 512 + tid; e < 16 * 64 * 128; e += nb * 512) {
        const int h = e >> 13; float hin = 0.f;
#pragma unroll 8
        for (int c = 0; c < 64; ++c) { const size_t off = (size_t)c * 131072 + e; HIN[off] = f2bf(hin);
            const float dec = __expf(ACUM[(size_t)(c * 128 + 127) * 16 + h]); hin = dec * hin + STATE[off]; }
    }
}

__device__ __forceinline__ void ssdb_item(const Args& a, LAS unsigned char* lds, int hc, int g, int tid) {
    unsigned char* ws = a.ws;
    const bf16_t* PROJ = (const bf16_t*)(ws + WS_PROJ); const float* ACUM = (const float*)(ws + WS_ACUM); const bf16_t* XS = (const bf16_t*)(ws + WS_XS);
    const bf16_t* CPOST = (const bf16_t*)(ws + WS_CPOST); const float* YDIAG = (const float*)(ws + WS_YDIAG); const bf16_t* HIN = (const bf16_t*)(ws + WS_HIN);
    bf16_t* MIXIN = (bf16_t*)(ws + WS_MIXIN);
    LAS float* ssq = (LAS float*)lds;
    const int w = tid >> 6, lane = tid & 63, fr = lane & 15, kq = lane >> 4;
    const int h = g * 8 + w, t0 = hc * 64, c = hc >> 1;
    f32x4 acc[4][4];
#pragma unroll
    for (int lt = 0; lt < 4; ++lt)
#pragma unroll
        for (int pt = 0; pt < 4; ++pt) acc[lt][pt] = (f32x4){0.f, 0.f, 0.f, 0.f};
    const bf16_t* hb = HIN + (size_t)(c * 16 + h) * 64 * 128;
#pragma unroll
    for (int ks = 0; ks < 4; ++ks) {
        bf16x8 cfr[4], hfr[4];
#pragma unroll
        for (int lt = 0; lt < 4; ++lt) cfr[lt] = *(const bf16x8*)(CPOST + (size_t)(t0 + 16 * lt + fr) * 256 + g * 128 + 32 * ks + 8 * kq);
#pragma unroll
        for (int pt = 0; pt < 4; ++pt) hfr[pt] = *(const bf16x8*)(hb + (size_t)(16 * pt + fr) * 128 + 32 * ks + 8 * kq);
#pragma unroll
        for (int lt = 0; lt < 4; ++lt)
#pragma unroll
            for (int pt = 0; pt < 4; ++pt) acc[lt][pt] = __builtin_amdgcn_mfma_f32_16x16x32_bf16(cfr[lt], hfr[pt], acc[lt][pt], 0, 0, 0);
    }
    const float dsk = a.in[I_DSKIP][h];
    float part[4][4];
#pragma unroll
    for (int lt = 0; lt < 4; ++lt)
#pragma unroll
        for (int r = 0; r < 4; ++r) {
            const int tok = t0 + 16 * lt + 4 * kq + r; const float ea = __expf(ACUM[(size_t)tok * 16 + h]); float sq = 0.f;
#pragma unroll
            for (int pt = 0; pt < 4; ++pt) { const int ch = h * 64 + 16 * pt + fr;
                const float xs = __uint_as_float((unsigned)XS[(size_t)tok * 1024 + ch] << 16); const float z = __uint_as_float((unsigned)PROJ[(size_t)tok * NINP + 1280 + ch] << 16);
                const float y = YDIAG[(size_t)tok * 1024 + ch] + acc[lt][pt][r] * ea + dsk * xs; const float gv = y * silu_f(z); acc[lt][pt][r] = gv; sq += gv * gv; }
            sq += __shfl_xor(sq, 1); sq += __shfl_xor(sq, 2); sq += __shfl_xor(sq, 4); sq += __shfl_xor(sq, 8);
            part[lt][r] = sq;
        }
    if (fr == 0) {
#pragma unroll
        for (int lt = 0; lt < 4; ++lt)
#pragma unroll
            for (int r = 0; r < 4; ++r) ssq[(16 * lt + 4 * kq + r) * 8 + w] = part[lt][r];
    }
    __syncthreads();
    const float* nw = a.in[I_NORMW];
#pragma unroll
    for (int lt = 0; lt < 4; ++lt)
#pragma unroll
        for (int r = 0; r < 4; ++r) {
            const int l = 16 * lt + 4 * kq + r; float tot = 0.f;
#pragma unroll
            for (int ww = 0; ww < 8; ++ww) tot += ssq[l * 8 + ww];
            const float rs = rsqrtf(tot * (1.f / 512.f) + LN_EPS);
#pragma unroll
            for (int pt = 0; pt < 4; ++pt) { const int ch = h * 64 + 16 * pt + fr; MIXIN[(size_t)(t0 + l) * D + 1024 + ch] = f2bf(acc[lt][pt][r] * rs * nw[ch]); }
        }
    __syncthreads();
}

__device__ __forceinline__ void phase8(const Args& a, int bid, int nb, int tid) {
    float* P = (float*)(a.ws + WS_PRE1); bf16_t* H = (bf16_t*)(a.ws + WS_H); const float* mod = (const float*)(a.ws + WS_MOD);
    const float* gam = a.in[I_LN1G]; const float* bet = a.in[I_LN1B];
    const int wave = tid >> 6, lane = tid & 63;
    for (int row = bid * 8 + wave; row < S; row += nb * 8) {
        float* pr = P + (size_t)row * D;
        f32x4 v[8]; float s = 0.f;
#pragma unroll
        for (int j = 0; j < 8; ++j) { v[j] = *(const f32x4*)(pr + 4 * lane + 256 * j); s += (v[j][0] + v[j][1]) + (v[j][2] + v[j][3]); }
        const float mean = wave_sum(s) * (1.f / D); float q = 0.f;
#pragma unroll
        for (int j = 0; j < 8; ++j) { v[j] = v[j] - mean; q += (v[j][0] * v[j][0] + v[j][1] * v[j][1]) + (v[j][2] * v[j][2] + v[j][3] * v[j][3]); }
        const float rstd = rsqrtf(wave_sum(q) * (1.f / D) + LN_EPS);
#pragma unroll
        for (int j = 0; j < 8; ++j) { const int col = 4 * lane + 256 * j;
            const f32x4 x1 = v[j] * rstd * *(const f32x4*)(gam + col) + *(const f32x4*)(bet + col);
            *(f32x4*)(pr + col) = x1;
            const f32x4 h2 = x1 * (*(const f32x4*)(mod + 4 * D + col) + 1.0f) + *(const f32x4*)(mod + 3 * D + col);
            u32x2 o; o.x = cvt_pk_bf16(h2[0], h2[1]); o.y = cvt_pk_bf16(h2[2], h2[3]);
            *(u32x2*)(H + (size_t)row * D + col) = o; }
    }
}

template <int NV> __device__ __forceinline__ float topk_thresh(const float (&x)[NV]) {
    float mx = x[0], mn = x[0];
#pragma unroll
    for (int i = 1; i < NV; ++i) { mx = fmaxf(mx, x[i]); mn = fminf(mn, x[i]); }
    mx = wave_max(mx); mn = wave_min(mn);
    float lo = mn - 1.0f, hi = mx;
    for (int it = 0; it < 48; ++it) {
        const float mid = 0.5f * (lo + hi);
        int cnt = 0;
#pragma unroll
        for (int i = 0; i < NV; ++i) cnt += __popcll(__ballot(x[i] > mid));
        if (cnt == 16) { lo = mid; break; }
        if (cnt > 16) lo = mid; else hi = mid;
    }
    return lo;
}
__device__ __forceinline__ int lane_prefix(unsigned long long m) { return __builtin_amdgcn_mbcnt_hi((unsigned)(m >> 32), __builtin_amdgcn_mbcnt_lo((unsigned)m, 0u)); }

__device__ __forceinline__ void phase10(const Args& a, LAS unsigned char* lds, int bid, int nb, int tid) {
    const float* SC = (const float*)(a.ws + WS_PROJ); int* IDS = (int*)(a.ws + WS_IDS); float* GATE = (float*)(a.ws + WS_GATE);
    const int wave = tid >> 6, lane = tid & 63;
    LAS float* vs = (LAS float*)(lds + wave * 512);
    LAS int* is = (LAS int*)(lds + wave * 512 + 256);
    for (int item = bid * 8 + wave; item < S * 8; item += nb * 8) {
        const int tok = item >> 3, h = item & 7;
        const float* sp = SC + (size_t)tok * D + h * 128;
#pragma unroll
        for (int half = 0; half < 2; ++half) {
            float x[2]; x[0] = sp[half * 1024 + lane]; x[1] = sp[half * 1024 + 64 + lane];
            const float lo = topk_thresh<2>(x);
            const unsigned long long m0 = __ballot(x[0] > lo), m1 = __ballot(x[1] > lo);
            const int p0 = lane_prefix(m0), p1 = __popcll(m0) + lane_prefix(m1);
            if (x[0] > lo && p0 < 16) { vs[half * 16 + p0] = x[0]; is[half * 16 + p0] = lane; }
            if (x[1] > lo && p1 < 16) { vs[half * 16 + p1] = x[1]; is[half * 16 + p1] = lane + 64; }
        }
        asm volatile("s_waitcnt lgkmcnt(0)" ::: "memory");
        const int ai = lane >> 2, b0 = (lane & 3) * 4;
        float cd[4]; const float va = vs[ai];
#pragma unroll
        for (int j = 0; j < 4; ++j) cd[j] = va + vs[16 + b0 + j];
        const float lo = topk_thresh<4>(cd);
        int base = 0;
#pragma unroll
        for (int j = 0; j < 4; ++j) { const unsigned long long m = __ballot(cd[j] > lo); const int p = base + lane_prefix(m);
            if (cd[j] > lo && p < 16) { vs[32 + p] = cd[j]; is[32 + p] = is[ai] * 128 + is[16 + b0 + j]; }
            base += __popcll(m); }
        asm volatile("s_waitcnt lgkmcnt(0)" ::: "memory");
        const float scv = vs[32 + (lane & 15)]; const int idv = is[32 + (lane & 15)];
        float m = scv; m = fmaxf(m, __shfl_xor(m, 1)); m = fmaxf(m, __shfl_xor(m, 2)); m = fmaxf(m, __shfl_xor(m, 4)); m = fmaxf(m, __shfl_xor(m, 8));
        const float e = __expf(scv - m); float sum = e; sum += __shfl_xor(sum, 1); sum += __shfl_xor(sum, 2); sum += __shfl_xor(sum, 4); sum += __shfl_xor(sum, 8);
        if (lane < 16) { IDS[(size_t)tok * 128 + h * 16 + lane] = idv; GATE[(size_t)tok * 128 + h * 16 + lane] = e / sum; }
        asm volatile("s_waitcnt lgkmcnt(0)" ::: "memory");
    }
}

__device__ __forceinline__ void phase11(const Args& a, int bid, int nb, int tid) {
    unsigned char* ws = a.ws;
    const bf16_t* H = (const bf16_t*)(ws + WS_H); const float* X1 = (const float*)(ws + WS_PRE1); const int* IDS = (const int*)(ws + WS_IDS); const float* GATE = (const float*)(ws + WS_GATE);
    const bf16_t* UT = (const bf16_t*)(ws + WS_UT); const bf16_t* VT = (const bf16_t*)(ws + WS_VT); const float* mod = (const float*)(ws + WS_MOD);
    const float* gam = a.in[I_LN2G]; const float* bet = a.in[I_LN2B]; float* out = a.out;
    const int wave = tid >> 6, lane = tid & 63;
    for (int tok = bid * 8 + wave; tok < S; tok += nb * 8) {
        float hv[32], acc[32];
#pragma unroll
        for (int j = 0; j < 4; ++j) { const u32x4 v = *(const u32x4*)(H + (size_t)tok * D + 8 * lane + 512 * j);
            hv[8 * j + 0] = bf_lo(v.x); hv[8 * j + 1] = bf_hi(v.x); hv[8 * j + 2] = bf_lo(v.y); hv[8 * j + 3] = bf_hi(v.y); hv[8 * j + 4] = bf_lo(v.z); hv[8 * j + 5] = bf_hi(v.z); hv[8 * j + 6] = bf_lo(v.w); hv[8 * j + 7] = bf_hi(v.w); }
#pragma unroll
        for (int i = 0; i < 32; ++i) acc[i] = 0.f;
        for (int k0 = 0; k0 < 128; k0 += 4) {
            int id[4]; float gt[4];
#pragma unroll
            for (int e = 0; e < 4; ++e) { id[e] = __builtin_amdgcn_readfirstlane(IDS[(size_t)tok * 128 + k0 + e]); gt[e] = GATE[(size_t)tok * 128 + k0 + e]; }
            u32x4 uv[4][4];
#pragma unroll
            for (int e = 0; e < 4; ++e)
#pragma unroll
                for (int j = 0; j < 4; ++j) uv[e][j] = *(const u32x4*)(UT + (size_t)id[e] * D + 8 * lane + 512 * j);
            float dot[4];
#pragma unroll
            for (int e = 0; e < 4; ++e) { float s = 0.f;
#pragma unroll
                for (int j = 0; j < 4; ++j) { const u32x4 v = uv[e][j];
                    s += hv[8 * j + 0] * bf_lo(v.x) + hv[8 * j + 1] * bf_hi(v.x) + hv[8 * j + 2] * bf_lo(v.y) + hv[8 * j + 3] * bf_hi(v.y) + hv[8 * j + 4] * bf_lo(v.z) + hv[8 * j + 5] * bf_hi(v.z) + hv[8 * j + 6] * bf_lo(v.w) + hv[8 * j + 7] * bf_hi(v.w); }
                dot[e] = s; }
#pragma unroll
            for (int e = 0; e < 4; ++e)
#pragma unroll
                for (int j = 0; j < 4; ++j) uv[e][j] = *(const u32x4*)(VT + (size_t)id[e] * D + 8 * lane + 512 * j);
#pragma unroll
            for (int e = 0; e < 4; ++e) { const float coef = gt[e] * gelu_erf(wave_sum(dot[e]));
#pragma unroll
                for (int j = 0; j < 4; ++j) { const u32x4 v = uv[e][j];
                    acc[8 * j + 0] += coef * bf_lo(v.x); acc[8 * j + 1] += coef * bf_hi(v.x); acc[8 * j + 2] += coef * bf_lo(v.y); acc[8 * j + 3] += coef * bf_hi(v.y);
                    acc[8 * j + 4] += coef * bf_lo(v.z); acc[8 * j + 5] += coef * bf_hi(v.z); acc[8 * j + 6] += coef * bf_lo(v.w); acc[8 * j + 7] += coef * bf_hi(v.w); } }
        }
        float s = 0.f;
#pragma unroll
        for (int j = 0; j < 4; ++j) { const int col = 8 * lane + 512 * j;
            const f32x4 xa = *(const f32x4*)(X1 + (size_t)tok * D + col), xb = *(const f32x4*)(X1 + (size_t)tok * D + col + 4);
            const f32x4 ga = *(const f32x4*)(mod + 5 * D + col), gb = *(const f32x4*)(mod + 5 * D + col + 4);
#pragma unroll
            for (int i = 0; i < 4; ++i) { acc[8 * j + i] = ALPHA * xa[i] + (1.f + ga[i]) * acc[8 * j + i]; acc[8 * j + 4 + i] = ALPHA * xb[i] + (1.f + gb[i]) * acc[8 * j + 4 + i]; }
#pragma unroll
            for (int i = 0; i < 8; ++i) s += acc[8 * j + i]; }
        const float mean = wave_sum(s) * (1.f / D); float q = 0.f;
#pragma unroll
        for (int i = 0; i < 32; ++i) { acc[i] -= mean; q += acc[i] * acc[i]; }
        const float rstd = rsqrtf(wave_sum(q) * (1.f / D) + LN_EPS);
#pragma unroll
        for (int j = 0; j < 4; ++j) { const int col = 8 * lane + 512 * j;
            const f32x4 ga = *(const f32x4*)(gam + col), gb = *(const f32x4*)(gam + col + 4), ba = *(const f32x4*)(bet + col), bb = *(const f32x4*)(bet + col + 4);
            f32x4 oa, ob;
#pragma unroll
            for (int i = 0; i < 4; ++i) { oa[i] = acc[8 * j + i] * rstd * ga[i] + ba[i]; ob[i] = acc[8 * j + 4 + i] * rstd * gb[i] + bb[i]; }
            *(f32x4*)(out + (size_t)tok * D + col) = oa; *(f32x4*)(out + (size_t)tok * D + col + 4) = ob; }
    }
}

__global__ void __launch_bounds__(512, 2) mega(Args args) {
    extern __shared__ __attribute__((aligned(16))) unsigned char lds_raw[];
    LAS unsigned char* lds = (LAS unsigned char*)lds_raw;
    const int tid = threadIdx.x, bid = blockIdx.x, nb = gridDim.x;
    const int lo = args.ph_lo, hi = args.ph_hi;
    unsigned char* ws = args.ws;
    volatile LAS unsigned* MISC = (volatile LAS unsigned*)(lds + LDS_BYTES - 64);
    XcdBarrier bar; bar.bar = (unsigned*)(ws + WS_CTL); bar.x = 0; bar.st = nullptr;
    if (hi - lo > 1) {
        if (tid < 16) MISC[tid] = 0u;
        __syncthreads();
        bar = xcd_barrier_post((unsigned*)(ws + WS_CTL), MISC + 8);
    }
#define IN(k) (lo <= (k) && (k) < hi)
#define SEAM(k) do { if (IN(k) && IN((k) + 1)) xcd_barrier(bar); } while (0)
    if (IN(0)) { phase0(args, lds, bid, nb, tid); } SEAM(0);
    if (IN(1)) { phase1(args, bid, nb, tid); } SEAM(1);
    if (IN(2)) { phase2(args, bid, nb, tid); } SEAM(2);
    if (IN(3)) {
        pg8::Gemm g{(const bf16_t*)(ws + WS_H), (const bf16_t*)(ws + WS_WIN), S, NINP, D}; pg8::StaticOrder so; so.init(S, NINP, nb, bid);
        pg8::EpiProj E{(bf16_t*)(ws + WS_PROJ), (float*)(ws + WS_DT), args.in[I_DTB]};
        pg8::gemm_phase<pg8::EpiProj, pg8::StaticOrder, true, true>(lds, g, so, E);
    } SEAM(3);
    if (IN(4)) {
        for (int item = bid; item < 2048; item += nb) {
            if (item < 1024) ssda_item(args, lds, item >> 4, item & 15, tid);
            else attn_item(args, lds, (item - 1024) >> 4, (item - 1024) & 15, tid);
        }
    } SEAM(4);
    if (IN(5)) { phase5(args, bid, nb, tid); } SEAM(5);
    if (IN(6)) { for (int item = bid; item < 256; item += nb) ssdb_item(args, lds, item >> 1, item & 1, tid); } SEAM(6);
    if (IN(7)) {
        pg8::Gemm g{(const bf16_t*)(ws + WS_MIXIN), (const bf16_t*)(ws + WS_WOUT), S, D, D}; pg8::StaticOrder so; so.init(S, D, nb, bid);
        pg8::EpiPre1 E{args.in[I_X], (const float*)(ws + WS_MOD) + 2 * D, (float*)(ws + WS_PRE1)};
        pg8::gemm_phase<pg8::EpiPre1, pg8::StaticOrder, true, true>(lds, g, so, E);
    } SEAM(7);
    if (IN(8)) { phase8(args, bid, nb, tid); } SEAM(8);
    if (IN(9)) {
        pg8::Gemm g{(const bf16_t*)(ws + WS_H), (const bf16_t*)(ws + WS_WSC), S, D, D}; pg8::StaticOrder so; so.init(S, D, nb, bid);
        pg8::EpiF32 E{(float*)(ws + WS_PROJ), D};
        pg8::gemm_phase<pg8::EpiF32, pg8::StaticOrder, true, true>(lds, g, so, E);
    } SEAM(9);
    if (IN(10)) { phase10(args, lds, bid, nb, tid); } SEAM(10);
    if (IN(11)) { phase11(args, bid, nb, tid); }
#undef IN
#undef SEAM
}

extern "C" void kernel_launch(void* const* d_in, const int* in_sizes, int n_in, void* d_out, int out_size, void* d_ws, size_t ws_size, hipStream_t stream) {
    static int grid = 0;
    if (grid == 0) {
        if (n_in != 23 || in_sizes[0] != S * D || out_size != S * D || ws_size < WS_END) { fprintf(stderr, "kernel_launch: unexpected shapes (n_in %d, in0 %d, out %d, ws %zu)\n", n_in, n_in > 0 ? in_sizes[0] : -1, out_size, ws_size); grid = -1; return; }
        int dev = 0, cus = 0, per_cu = 0;
        if (hipGetDevice(&dev) != hipSuccess || hipDeviceGetAttribute(&cus, hipDeviceAttributeMultiprocessorCount, dev) != hipSuccess) { grid = -1; return; }
        if (hipFuncSetAttribute((const void*)mega, hipFuncAttributeMaxDynamicSharedMemorySize, LDS_BYTES) != hipSuccess) { fprintf(stderr, "kernel_launch: hipFuncSetAttribute failed\n"); grid = -1; return; }
        if (hipOccupancyMaxActiveBlocksPerMultiprocessor(&per_cu, (const void*)mega, 512, LDS_BYTES) != hipSuccess || per_cu < 1) { fprintf(stderr, "kernel_launch: occupancy query says %d blocks/CU\n", per_cu); (void)hipGetLastError(); grid = -1; return; }
        grid = cus;
    }
    if (grid < 0) return;
    (void)hipMemsetAsync((char*)d_ws + WS_CTL, 0, CTL_ZERO_BYTES, stream);
    Args a{};
    for (int i = 0; i < 23; ++i) a.in[i] = (const float*)d_in[i];
    a.out = (float*)d_out; a.ws = (unsigned char*)d_ws;
    constexpr int NL = MK_N_LAUNCHES;
    for (int li = 0; li < NL; ++li) {
        a.ph_lo = (NL == NPH) ? li : (li * NPH) / NL; a.ph_hi = (NL == NPH) ? li + 1 : ((li + 1) * NPH) / NL;
        hipLaunchKernelGGL(mega, dim3(grid), dim3(512), LDS_BYTES, stream, a);
    }
}
```

```cpp
#include <hip/hip_runtime.h>
#include <cstdio>
#include <cstdint>

#ifndef MK_N_LAUNCHES
#define MK_N_LAUNCHES 1
#endif

#define LAS __attribute__((address_space(3)))
#define GAS __attribute__((address_space(1)))
typedef unsigned short bf16_t;
typedef short bf16x8 __attribute__((ext_vector_type(8)));
typedef float f32x4 __attribute__((ext_vector_type(4)));
typedef float f32x2 __attribute__((ext_vector_type(2)));
typedef unsigned u32x4 __attribute__((ext_vector_type(4)));
typedef unsigned u32x2 __attribute__((ext_vector_type(2)));

constexpr int S = 8192, D = 2048, NIN = 3856, NINP = 4096;
constexpr int NPH = 15;
constexpr float ALPHA = 1.189207115002721f;
constexpr float LN_EPS = 1e-5f;

constexpr size_t MiB = 1u << 20;
constexpr size_t WS_CTL = 0, CTL_ZERO_BYTES = 64 * 1024;
constexpr size_t WS_MODP = 1 * MiB;
constexpr size_t WS_MOD = 3 * MiB;
constexpr size_t WS_ROPE = 3 * MiB + 512 * 1024;
constexpr size_t WS_WIN = 4 * MiB;
constexpr size_t WS_WOUT = 20 * MiB;
constexpr size_t WS_WSC = 28 * MiB;
constexpr size_t WS_H = 36 * MiB;
constexpr size_t WS_PROJ = 68 * MiB;
constexpr size_t WS_DT = 132 * MiB;
constexpr size_t WS_ACUM = 132 * MiB + 512 * 1024;
constexpr size_t WS_XS = 133 * MiB;
constexpr size_t WS_CPOST = 149 * MiB;
constexpr size_t WS_YDIAG = 153 * MiB;
constexpr size_t WS_STATE = 185 * MiB;
constexpr size_t WS_HIN = 217 * MiB;
constexpr size_t WS_MIXIN = 233 * MiB;
constexpr size_t WS_PRE1 = 265 * MiB;
constexpr size_t WS_IDC = 329 * MiB;
constexpr size_t WS_TK = 331 * MiB;
constexpr size_t WS_GATEC = 333 * MiB;
constexpr size_t WS_UQ = 340 * MiB;
constexpr size_t WS_H2Q = 372 * MiB;
constexpr size_t WS_VQ = 404 * MiB;
constexpr size_t WS_LIST = 436 * MiB;
constexpr size_t WS_OFFS = 440 * MiB;
constexpr size_t WS_PAIRV = 443 * MiB;
constexpr size_t WS_PART = WS_PROJ;
constexpr size_t WS_FFNT = WS_YDIAG;
constexpr size_t WS_END = 448 * MiB;

constexpr int LDS_BYTES = 147456;

__device__ __forceinline__ unsigned cvt_pk_bf16(float lo, float hi) { unsigned r; asm volatile("v_cvt_pk_bf16_f32 %0, %1, %2" : "=v"(r) : "v"(lo), "v"(hi)); return r; }
__device__ __forceinline__ float bf_lo(unsigned u) { return __uint_as_float(u << 16); }
__device__ __forceinline__ float bf_hi(unsigned u) { return __uint_as_float(u & 0xffff0000u); }
__device__ __forceinline__ bf16_t f2bf(float f) { return (bf16_t)(cvt_pk_bf16(f, 0.f) & 0xffffu); }
__device__ __forceinline__ float wave_sum(float v) {
#pragma unroll
    for (int o = 1; o < 64; o <<= 1) v += __shfl_xor(v, o);
    return v;
}
__device__ __forceinline__ float wave_max(float v) {
#pragma unroll
    for (int o = 1; o < 64; o <<= 1) v = fmaxf(v, __shfl_xor(v, o));
    return v;
}
__device__ __forceinline__ float wave_min(float v) {
#pragma unroll
    for (int o = 1; o < 64; o <<= 1) v = fminf(v, __shfl_xor(v, o));
    return v;
}
__device__ __forceinline__ float silu_f(float v) { return v / (1.f + __expf(-v)); }
__device__ __forceinline__ float softplus_f(float v) { return v > 20.f ? v : log1pf(__expf(v)); }
__device__ __forceinline__ float gelu_erf(float v) { return 0.5f * v * (1.f + erff(v * 0.70710678118654752f)); }

namespace pg8 {
constexpr int BM = 256, BK = 64, HALF = 128, HTB = HALF * BK * 2, STAGE_BYTES = 8 * HTB, NXCD = 8, WGM = 8;
__host__ __device__ __forceinline__ int lds_byte(int r, int c) { const int st = (r >> 4) * 2 + (c >> 5), rr = r & 15, cc = c & 31, ob = rr * 64 + cc * 2; return st * 1024 + (ob ^ (((ob >> 9) & 1) << 5)); }
__host__ __device__ __forceinline__ void stage_rc(int b, int& R, int& C) { const int st = b / 1024, sb = b % 1024, swz = sb ^ (((sb >> 9) & 1) << 5); R = (st >> 1) * 16 + swz / 64; C = (st & 1) * 32 + (swz % 64) / 2; }
__host__ __device__ __forceinline__ int perm32(int rho) { const int n = rho >> 4, i = rho & 15; return 8 * (i >> 2) + 4 * n + (i & 3); }

struct Unit { int pm, pn; };
struct Gemm { const bf16_t* A; const bf16_t* Bt; int M, N, K; };

struct StaticOrder {
    int nM, nN, nwg, G, c;
    __host__ __device__ void init(int M, int N, int G_, int c_) { nM = M / BM; nN = N / BM; nwg = nM * nN; G = G_; c = c_; }
    __host__ __device__ bool next(int i, Unit& u) const {
        const long L = (long)i * G + c; if (L >= nwg) return false;
        int wgid = (int)L; { const int q = nwg / NXCD, r = nwg % NXCD, xcd = wgid % NXCD, off = wgid / NXCD; wgid = (xcd < r ? xcd * (q + 1) : r * (q + 1) + (xcd - r) * q) + off; }
        const int nig = WGM * nN, gid = wgid / nig, fm = gid * WGM, gsz = (nM - fm) < WGM ? (nM - fm) : WGM;
        u.pm = fm + ((wgid % nig) % gsz); u.pn = (wgid % nig) / gsz; return true;
    }
    __device__ __forceinline__ void a_ready(const Unit&) const {}
    __device__ __forceinline__ void done(const Unit&) const {}
};

struct EpiProj {
    static constexpr bool PERM = true, AFTER_DRAIN = false;
    bf16_t* O; float* DT; const float* dt_bias;
    __device__ __forceinline__ void operator()(const f32x4 (&acc)[2][2][4][2], const Unit& u, int wr, int wc, int fr, int fq) const {
        const int row0 = u.pm * BM + wr * 64 + fr; const int col0 = u.pn * BM + wc * 32 + 8 * fq;
#pragma unroll
        for (int ai = 0; ai < 2; ++ai)
#pragma unroll
            for (int m = 0; m < 4; ++m) { bf16_t* rowp = O + (size_t)(row0 + ai * HALF + m * 16) * NINP + col0;
#pragma unroll
                for (int bj = 0; bj < 2; ++bj) { const f32x4 v0 = acc[ai][bj][m][0], v1 = acc[ai][bj][m][1];
                    u32x4 w; w.x = cvt_pk_bf16(v0[0], v0[1]); w.y = cvt_pk_bf16(v0[2], v0[3]); w.z = cvt_pk_bf16(v1[0], v1[1]); w.w = cvt_pk_bf16(v1[2], v1[3]);
                    *(u32x4*)(rowp + bj * HALF) = w; } }
        if (u.pn == 15 && wc == 0 && fq < 2) {
            float bias[8];
#pragma unroll
            for (int i = 0; i < 8; ++i) bias[i] = dt_bias[8 * fq + i];
#pragma unroll
            for (int ai = 0; ai < 2; ++ai)
#pragma unroll
                for (int m = 0; m < 4; ++m) { float* dp = DT + (size_t)(row0 + ai * HALF + m * 16) * 16 + 8 * fq; const f32x4 v0 = acc[ai][0][m][0], v1 = acc[ai][0][m][1];
                    f32x4 o0, o1;
#pragma unroll
                    for (int i = 0; i < 4; ++i) { o0[i] = softplus_f(v0[i] + bias[i]); o1[i] = softplus_f(v1[i] + bias[4 + i]); }
                    *(f32x4*)dp = o0; *(f32x4*)(dp + 4) = o1; }
        }
    }
};
struct EpiPre1 {
    static constexpr bool PERM = false, AFTER_DRAIN = false;
    const float* X; const float* g1; float* O;
    __device__ __forceinline__ void operator()(const f32x4 (&acc)[2][2][4][2], const Unit& u, int wr, int wc, int fr, int fq) const {
        const int row0 = u.pm * BM + wr * 64 + fr; const int col0 = u.pn * BM + wc * 32 + 4 * fq;
        f32x4 gv[2][2];
#pragma unroll
        for (int bj = 0; bj < 2; ++bj)
#pragma unroll
            for (int n = 0; n < 2; ++n) gv[bj][n] = *(const f32x4*)(g1 + col0 + bj * HALF + n * 16) + 1.0f;
#pragma unroll
        for (int ai = 0; ai < 2; ++ai)
#pragma unroll
            for (int m = 0; m < 4; ++m) { const size_t off = (size_t)(row0 + ai * HALF + m * 16) * D + col0;
#pragma unroll
                for (int bj = 0; bj < 2; ++bj)
#pragma unroll
                    for (int n = 0; n < 2; ++n) { const f32x4 xv = *(const f32x4*)(X + off + bj * HALF + n * 16);
                        *(f32x4*)(O + off + bj * HALF + n * 16) = xv * ALPHA + gv[bj][n] * acc[ai][bj][m][n]; } }
    }
};
struct EpiF32 {
    static constexpr bool PERM = false, AFTER_DRAIN = false;
    float* O; int ldc;
    __device__ __forceinline__ void operator()(const f32x4 (&acc)[2][2][4][2], const Unit& u, int wr, int wc, int fr, int fq) const {
        const int row0 = u.pm * BM + wr * 64 + fr; const int col0 = u.pn * BM + wc * 32 + 4 * fq;
#pragma unroll
        for (int ai = 0; ai < 2; ++ai)
#pragma unroll
            for (int m = 0; m < 4; ++m) { const size_t off = (size_t)(row0 + ai * HALF + m * 16) * ldc + col0;
#pragma unroll
                for (int bj = 0; bj < 2; ++bj)
#pragma unroll
                    for (int n = 0; n < 2; ++n) *(f32x4*)(O + off + bj * HALF + n * 16) = acc[ai][bj][m][n]; }
    }
};

template <class Epi, class Sched, bool ALIGN_EPI = false, bool SP2 = false>
__device__ __forceinline__ void gemm_phase(LAS unsigned char* lds, const Gemm g, const Sched& S, const Epi& E) {
    const int tid = threadIdx.x, wid = __builtin_amdgcn_readfirstlane(tid >> 6), lane = tid & 63, wr = wid >> 2, wc = wid & 3, fr = lane & 15, fq = lane >> 4;
    const int K = g.K, nt = K / BK;
    unsigned voffA[2], voffB[2];
#pragma unroll
    for (int i = 0; i < 2; ++i) { int R, C; stage_rc(tid * 16 + i * 8192, R, C); const int Rb = Epi::PERM ? ((R & ~31) + perm32(R & 31)) : R;
        voffA[i] = (unsigned)(R * K + C) * 2u; voffB[i] = (unsigned)(Rb * K + C) * 2u; }
    const size_t kstep = (size_t)(BK * 2);
    const size_t hstep = (size_t)HALF * K * 2;
    const size_t tstep = 2 * hstep;
    const unsigned ldsw = (unsigned)wid * 1024u;
    const int aoff = lds_byte(wr * 64 + fr, fq * 8), boff = lds_byte(wc * 32 + fr, fq * 8);
#define PG8_SA(b, h) (((b) * 2 + (h)) * HTB)
#define PG8_SB(b, h) ((4 + (b) * 2 + (h)) * HTB)
#define PG8_STAGE(bufoff, gbase, voff) do { _Pragma("unroll") for (int _i = 0; _i < 2; ++_i) \
        __builtin_amdgcn_global_load_lds((const unsigned*)((const char*)(gbase) + (voff)[_i]), (LAS unsigned*)(lds + (bufoff) + ldsw + _i * 8192), 16, 0, 0); } while (0)
#define PG8_LDA(dst, b, h) do { _Pragma("unroll") for (int m = 0; m < 4; ++m) _Pragma("unroll") for (int k = 0; k < 2; ++k) dst[m][k] = *(const LAS bf16x8*)(lds + PG8_SA(b, h) + aoff + m * 2048 + k * 1024); } while (0)
#define PG8_LDB(dst, b, h) do { _Pragma("unroll") for (int n = 0; n < 2; ++n) _Pragma("unroll") for (int k = 0; k < 2; ++k) dst[n][k] = *(const LAS bf16x8*)(lds + PG8_SB(b, h) + boff + n * 2048 + k * 1024); } while (0)
#define PG8_MMA(ai, bj, At, Bt) do { __builtin_amdgcn_s_setprio(1); _Pragma("unroll") for (int m = 0; m < 4; ++m) _Pragma("unroll") for (int n = 0; n < 2; ++n) _Pragma("unroll") for (int k = 0; k < 2; ++k) \
        acc[ai][bj][m][n] = __builtin_amdgcn_mfma_f32_16x16x32_bf16(Bt[n][k], At[m][k], acc[ai][bj][m][n], 0, 0, 0); __builtin_amdgcn_s_setprio(0); } while (0)
#define PG8_WAIT_V(n) asm volatile("s_waitcnt vmcnt(" #n ")" ::: "memory")
#define PG8_WAIT_L(n) asm volatile("s_waitcnt lgkmcnt(" #n ")" ::: "memory")
#define PG8_BAR __builtin_amdgcn_s_barrier()
#define PG8_SCHED __builtin_amdgcn_sched_barrier(0)
    Unit cur, nxt; int ui = 0;
    if (!S.next(0, cur)) return;
    f32x4 acc[2][2][4][2];
#pragma unroll
    for (int a = 0; a < 2; ++a)
#pragma unroll
        for (int b = 0; b < 2; ++b)
#pragma unroll
            for (int m = 0; m < 4; ++m)
#pragma unroll
                for (int n = 0; n < 2; ++n) acc[a][b][m][n] = (f32x4){0.f, 0.f, 0.f, 0.f};
    bf16x8 At[4][2], B0[2][2], B1[2][2];
    const char* cA = (const char*)g.A + (size_t)cur.pm * tstep; const char* cB = (const char*)g.Bt + (size_t)cur.pn * tstep;
    S.a_ready(cur);
    if constexpr (SP2) {
        PG8_STAGE(PG8_SB(0, 0), cB, voffB); PG8_STAGE(PG8_SB(0, 1), cB + hstep, voffB); PG8_STAGE(PG8_SA(0, 0), cA, voffA); PG8_STAGE(PG8_SA(0, 1), cA + hstep, voffA);
        if (wr == 1) PG8_BAR;
        PG8_WAIT_V(2); PG8_BAR;
        PG8_STAGE(PG8_SB(1, 0), cB + kstep, voffB); PG8_STAGE(PG8_SA(1, 0), cA + kstep, voffA); PG8_STAGE(PG8_SB(1, 1), cB + hstep + kstep, voffB);
        PG8_WAIT_V(6); PG8_BAR;
    } else {
        PG8_STAGE(PG8_SB(0, 0), cB, voffB); PG8_STAGE(PG8_SA(0, 0), cA, voffA); PG8_STAGE(PG8_SB(0, 1), cB + hstep, voffB); PG8_STAGE(PG8_SA(0, 1), cA + hstep, voffA);
        if (wr == 1) PG8_BAR;
        PG8_WAIT_V(4); PG8_BAR;
        PG8_STAGE(PG8_SB(1, 0), cB + kstep, voffB); PG8_STAGE(PG8_SA(1, 0), cA + kstep, voffA); PG8_STAGE(PG8_SB(1, 1), cB + hstep + kstep, voffB);
        PG8_WAIT_V(6); PG8_BAR;
    }
    for (;;) {
        const bool has_next = S.next(ui + 1, nxt);
        const char* nA = has_next ? (const char*)g.A + (size_t)nxt.pm * tstep : cA; const char* nB = has_next ? (const char*)g.Bt + (size_t)nxt.pn * tstep : cB;
        for (int t = 0; t < nt; t += 2) {
            const bool last = (t == nt - 2);
            const char* a1 = cA + (size_t)(t + 1) * kstep;
            const char* a2 = last ? nA : cA + (size_t)(t + 2) * kstep; const char* b2 = last ? nB : cB + (size_t)(t + 2) * kstep;
            const char* a3 = a2 + kstep; const char* b3 = b2 + kstep;
            if (last && has_next) S.a_ready(nxt);
            if constexpr (SP2) {
            PG8_LDB(B0, 0, 0); PG8_LDB(B1, 0, 1); PG8_SCHED; PG8_LDA(At, 0, 0); PG8_STAGE(PG8_SA(1, 1), a1 + hstep, voffA);
            PG8_WAIT_V(8); PG8_WAIT_L(0); PG8_BAR; PG8_MMA(0, 0, At, B0); PG8_MMA(0, 1, At, B1); PG8_BAR; PG8_SCHED;
            PG8_LDA(At, 0, 1); PG8_STAGE(PG8_SB(0, 0), b2, voffB); PG8_STAGE(PG8_SB(0, 1), b2 + hstep, voffB); PG8_STAGE(PG8_SA(0, 0), a2, voffA);
            PG8_WAIT_V(8); PG8_WAIT_L(0); PG8_BAR; PG8_MMA(1, 0, At, B0); PG8_MMA(1, 1, At, B1); PG8_BAR; PG8_SCHED;
            PG8_LDB(B0, 1, 0); PG8_LDB(B1, 1, 1); PG8_SCHED; PG8_LDA(At, 1, 0); PG8_STAGE(PG8_SA(0, 1), a2 + hstep, voffA);
            PG8_WAIT_V(8); PG8_WAIT_L(0); PG8_BAR; PG8_MMA(0, 0, At, B0); PG8_MMA(0, 1, At, B1); PG8_BAR; PG8_SCHED;
            PG8_LDA(At, 1, 1); PG8_STAGE(PG8_SB(1, 0), b3, voffB); PG8_STAGE(PG8_SB(1, 1), b3 + hstep, voffB); PG8_STAGE(PG8_SA(1, 0), a3, voffA);
            PG8_WAIT_V(8); PG8_WAIT_L(0); PG8_BAR; PG8_MMA(1, 0, At, B0); PG8_MMA(1, 1, At, B1); PG8_BAR; PG8_SCHED;
            } else {
            PG8_LDB(B0, 0, 0); PG8_SCHED; PG8_LDA(At, 0, 0); PG8_STAGE(PG8_SA(1, 1), a1 + hstep, voffA);
            PG8_WAIT_L(8); PG8_BAR; PG8_WAIT_L(0); PG8_MMA(0, 0, At, B0); PG8_BAR; PG8_SCHED;
            PG8_LDB(B1, 0, 1); PG8_STAGE(PG8_SB(0, 0), b2, voffB);
            PG8_BAR; PG8_WAIT_L(0); PG8_MMA(0, 1, At, B1); PG8_BAR;
            PG8_LDA(At, 0, 1); PG8_STAGE(PG8_SA(0, 0), a2, voffA);
            PG8_BAR; PG8_WAIT_L(0); PG8_MMA(1, 0, At, B0); PG8_BAR; PG8_SCHED;
            PG8_STAGE(PG8_SB(0, 1), b2 + hstep, voffB);
            PG8_WAIT_V(6); PG8_BAR; PG8_MMA(1, 1, At, B1); PG8_BAR;
            PG8_LDB(B0, 1, 0); PG8_SCHED; PG8_LDA(At, 1, 0); PG8_STAGE(PG8_SA(0, 1), a2 + hstep, voffA);
            PG8_WAIT_L(8); PG8_BAR; PG8_WAIT_L(0); PG8_MMA(0, 0, At, B0); PG8_BAR; PG8_SCHED;
            PG8_LDB(B1, 1, 1); PG8_STAGE(PG8_SB(1, 0), b3, voffB);
            PG8_BAR; PG8_WAIT_L(0); PG8_MMA(0, 1, At, B1); PG8_BAR;
            PG8_LDA(At, 1, 1); PG8_STAGE(PG8_SA(1, 0), a3, voffA);
            PG8_BAR; PG8_WAIT_L(0); PG8_MMA(1, 0, At, B0); PG8_BAR; PG8_SCHED;
            PG8_STAGE(PG8_SB(1, 1), b3 + hstep, voffB);
            PG8_WAIT_V(6); PG8_BAR; PG8_MMA(1, 1, At, B1); PG8_BAR;
            }
        }
        if constexpr (ALIGN_EPI) { if (wr == 0) PG8_BAR; }
        if constexpr (!Epi::AFTER_DRAIN) { E(acc, cur, wr, wc, fr, fq); S.done(cur); }
        if (!has_next) break;
#pragma unroll
        for (int a = 0; a < 2; ++a)
#pragma unroll
            for (int b = 0; b < 2; ++b)
#pragma unroll
                for (int m = 0; m < 4; ++m)
#pragma unroll
                    for (int n = 0; n < 2; ++n) acc[a][b][m][n] = (f32x4){0.f, 0.f, 0.f, 0.f};
        cur = nxt; cA = nA; cB = nB; ++ui;
        if constexpr (ALIGN_EPI) { if (wr == 1) PG8_BAR; }
    }
    PG8_WAIT_V(0);
    if constexpr (!ALIGN_EPI) { if (wr == 0) PG8_BAR; }
    PG8_BAR;
#undef PG8_SA
#undef PG8_SB
#undef PG8_STAGE
#undef PG8_LDA
#undef PG8_LDB
#undef PG8_MMA
#undef PG8_WAIT_V
#undef PG8_WAIT_L
#undef PG8_BAR
#undef PG8_SCHED
}
}

typedef GAS unsigned gu32;
#define XB_TMO      128
#define XB_XCNT(j)  (256  + 64 * (j))
#define XB_XSUB(j)  (1280 + 64 * (j))
#define XB_XGEN(j)  (2304 + 64 * (j))
#define XB_TOP      3328
#define XB_TOPGEN   3392
#define XCD_BAR_WORDS 3456
#define XB_SPIN_CAP (1u << 22)
__device__ __forceinline__ unsigned xb_ld(unsigned* p)              { return __hip_atomic_load(p, __ATOMIC_RELAXED, __HIP_MEMORY_SCOPE_AGENT); }
__device__ __forceinline__ unsigned xb_add(unsigned* p, unsigned v) { return __hip_atomic_fetch_add(p, v, __ATOMIC_RELAXED, __HIP_MEMORY_SCOPE_AGENT); }
__device__ __forceinline__ unsigned xb_xcc_id() { return (unsigned)__builtin_amdgcn_s_getreg((3 << 11) | 20) & 0xFu; }
#define XB_SPIN(cond, bar) do { unsigned _sp = 0; while (cond) { __builtin_amdgcn_s_sleep(1); \
    if ((++_sp & 255u) == 0u) { if (xb_ld(&(bar)[XB_TMO])) break; if (_sp > XB_SPIN_CAP) { atomicAdd(&(bar)[XB_TMO], 1u); break; } } } } while (0)
struct XcdBarrier { unsigned* bar; unsigned x; volatile LAS unsigned* st; };
__device__ __forceinline__ XcdBarrier xcd_barrier_post(unsigned* bar, volatile LAS unsigned* st) {
    XcdBarrier b; b.bar = bar; b.x = xb_xcc_id(); b.st = st;
    if (threadIdx.x == 0) (void)xb_add(&bar[XB_XCNT(b.x)], 1u);
    return b;
}
__device__ __forceinline__ void xcd_barrier_complete(unsigned* bar, unsigned x, unsigned& nloc, unsigned& nx) {
    const unsigned G = gridDim.x * gridDim.y * gridDim.z;
    unsigned sum, cnt, mine, sp = 0u;
    for (;;) {
        sum = 0u; cnt = 0u; mine = 0u;
#pragma unroll
        for (unsigned j = 0; j < 16; ++j) { const unsigned c = xb_ld(&bar[XB_XCNT(j)]); sum += c; cnt += (c > 0u) ? 1u : 0u; mine = (j == x) ? c : mine; }
        if (sum == G) break;
        __builtin_amdgcn_s_sleep(1);
        if ((++sp & 255u) == 0u) { if (xb_ld(&bar[XB_TMO])) break; if (sp > XB_SPIN_CAP) { atomicAdd(&bar[XB_TMO], 1u); break; } }
    }
    nloc = mine > 0u ? mine : 1u; nx = cnt > 0u ? cnt : 1u;
}
__device__ __forceinline__ void xcd_barrier(const XcdBarrier& b) {
    asm volatile("s_waitcnt vmcnt(0)" ::: "memory");
    __syncthreads();
    if (threadIdx.x == 0) {
        unsigned* bar = b.bar;
        __builtin_amdgcn_s_waitcnt(0);
        unsigned nloc = b.st[0], nx = b.st[1];
        if (nloc == 0u) { xcd_barrier_complete(bar, b.x, nloc, nx); b.st[0] = nloc; b.st[1] = nx; }
        const unsigned old = xb_add(&bar[XB_XSUB(b.x)], 1u);
        const unsigned gen = old / nloc;
        if (old + 1u == (gen + 1u) * nloc) {
            __builtin_amdgcn_fence(__ATOMIC_RELEASE, "agent");
            asm volatile("s_waitcnt vmcnt(0)" ::: "memory");
            const unsigned og = xb_add(&bar[XB_TOP], 1u);
            const unsigned tg = og / nx;
            if (og + 1u == (tg + 1u) * nx) xb_add(&bar[XB_TOPGEN], 1u);
            else XB_SPIN(xb_ld(&bar[XB_TOPGEN]) == tg, bar);
            __builtin_amdgcn_fence(__ATOMIC_ACQUIRE, "agent");
            xb_add(&bar[XB_XGEN(b.x)], 1u);
            asm volatile("s_waitcnt vmcnt(0)" ::: "memory");
        } else {
            XB_SPIN(xb_ld(&bar[XB_XGEN(b.x)]) == gen, bar);
            __builtin_amdgcn_fence(__ATOMIC_ACQUIRE, "agent");
            asm volatile("s_waitcnt vmcnt(0)" ::: "memory");
        }
    }
    __syncthreads();
}

struct Args { const float* in[23]; float* out; unsigned char* ws; int ph_lo, ph_hi; };
enum { I_X = 0, I_C, I_POS, I_WADA, I_BADA, I_WIN, I_CONVW, I_CONVB, I_DTB, I_ALOG, I_DSKIP, I_NORMW, I_SINK, I_WOUT, I_LN1G, I_LN1B, I_WQ, I_K1, I_K2, I_U, I_V, I_LN2G, I_LN2B };

__device__ __forceinline__ void p0_transpose_item(const float* W, int K, int N, int Npad, bf16_t* WT, LAS float* scr, int item, int lane) {
    const int nblk = Npad / 32, kb = item / nblk, nb = item % nblk, k0 = 64 * kb, n0 = 32 * nb;
    const int ncol = n0 + (lane & 31);
#pragma unroll 8
    for (int i = 0; i < 32; ++i) { const int kk = 2 * i + (lane >> 5); scr[kk * 33 + (lane & 31)] = (ncol < N) ? W[(size_t)(k0 + kk) * N + ncol] : 0.f; }
    asm volatile("s_waitcnt lgkmcnt(0)" ::: "memory");
    const int c = lane & 7;
#pragma unroll
    for (int j = 0; j < 4; ++j) { const int n = (lane >> 3) + 8 * j; const LAS float* s = scr + (8 * c) * 33 + n;
        u32x4 o; o.x = cvt_pk_bf16(s[0 * 33], s[1 * 33]); o.y = cvt_pk_bf16(s[2 * 33], s[3 * 33]); o.z = cvt_pk_bf16(s[4 * 33], s[5 * 33]); o.w = cvt_pk_bf16(s[6 * 33], s[7 * 33]);
        *(u32x4*)(WT + (size_t)(n0 + n) * K + k0 + 8 * c) = o; }
    asm volatile("s_waitcnt lgkmcnt(0)" ::: "memory");
}

__device__ __forceinline__ void phase0(const Args& a, LAS unsigned char* lds, int bid, int nb, int tid) {
    unsigned char* ws = a.ws;
    const int wave = tid >> 6, lane = tid & 63;
    {
        const float* c = a.in[I_C]; const float* w_ada = a.in[I_WADA]; float* modp = (float*)(ws + WS_MODP);
        for (int item = bid; item < 256; item += nb) {
            const int kc = item >> 3, ns = item & 7, k0 = kc * 64, n0 = ns * 1536;
            if (tid < 384) {
                f32x4 acc = {0.f, 0.f, 0.f, 0.f};
                const float* wp = w_ada + (size_t)k0 * 12288 + n0 + tid * 4;
#pragma unroll 8
                for (int k = 0; k < 64; ++k) { const float cv = c[k0 + k]; const float s = cv / (1.f + __expf(-cv)); const f32x4 w = *(const f32x4*)(wp + (size_t)k * 12288); acc += w * s; }
                *(f32x4*)(modp + (size_t)kc * 12288 + n0 + tid * 4) = acc;
            }
        }
    }
    {
        LAS float* scr = (LAS float*)(lds + wave * 16384);
        const int gw = bid * 8 + wave, NGW = nb * 8;
        constexpr int I_IN = (D / 64) * (NINP / 32), I_OUT = (D / 64) * (D / 32);
        for (int it = gw; it < I_IN + I_OUT; it += NGW) {
            if (it < I_IN) p0_transpose_item(a.in[I_WIN], D, NIN, NINP, (bf16_t*)(ws + WS_WIN), scr, it, lane);
            else p0_transpose_item(a.in[I_WOUT], D, D, D, (bf16_t*)(ws + WS_WOUT), scr, it - I_IN, lane);
        }
    }
    __syncthreads();
    {
        LAS float* keyS = (LAS float*)lds;
        LAS float* wqS = keyS + 128 * 65;
        bf16_t* WSC = (bf16_t*)(ws + WS_WSC);
        for (int item = bid; item < 512; item += nb) {
            const int half = item & 1, h = (item >> 1) & 7, db = item >> 4, d0 = db * 64;
            const float* keys = a.in[half ? I_K2 : I_K1];
            const float* wq = a.in[I_WQ];
#pragma unroll
            for (int i = 0; i < 16; ++i) { const int e = tid + i * 512; keyS[(e >> 6) * 65 + (e & 63)] = keys[e]; }
#pragma unroll
            for (int i = 0; i < 8; ++i) { const int e = tid + i * 512; const int dd = e >> 6, k = e & 63; wqS[dd * 65 + k] = wq[(size_t)(d0 + dd) * 1024 + h * 128 + half * 64 + k]; }
            __syncthreads();
            const int dd = tid & 63, ng = tid >> 6;
            float acc[16];
#pragma unroll
            for (int i = 0; i < 16; ++i) acc[i] = 0.f;
            for (int k = 0; k < 64; ++k) { const float wv = wqS[dd * 65 + k];
#pragma unroll
                for (int i = 0; i < 16; ++i) acc[i] += wv * keyS[(ng * 16 + i) * 65 + k]; }
#pragma unroll
            for (int i = 0; i < 16; ++i) WSC[(size_t)(half * 1024 + h * 128 + ng * 16 + i) * D + d0 + dd] = f2bf(acc[i]);
            __syncthreads();
        }
    }
    {
        const size_t nthr = (size_t)nb * 512, gt = (size_t)bid * 512 + tid;
        const float* U = a.in[I_U]; unsigned char* UQ = ws + WS_UQ;
        for (size_t i = gt; i < (size_t)16384 * 128; i += nthr) {
            const int e = (int)(i >> 7), j16 = (int)(i & 127), sl = j16 >> 3, c = j16 & 7, g = e >> 10, el = e & 1023;
            const float* src = U + (size_t)e * D + j16 * 16;
            const f32x4 v0 = *(const f32x4*)src * 64.f, v1 = *(const f32x4*)(src + 4) * 64.f, v2 = *(const f32x4*)(src + 8) * 64.f, v3 = *(const f32x4*)(src + 12) * 64.f;
            u32x4 o = {0u, 0u, 0u, 0u};
            o.x = __builtin_amdgcn_cvt_pk_fp8_f32(v0[0], v0[1], o.x, false); o.x = __builtin_amdgcn_cvt_pk_fp8_f32(v0[2], v0[3], o.x, true);
            o.y = __builtin_amdgcn_cvt_pk_fp8_f32(v1[0], v1[1], o.y, false); o.y = __builtin_amdgcn_cvt_pk_fp8_f32(v1[2], v1[3], o.y, true);
            o.z = __builtin_amdgcn_cvt_pk_fp8_f32(v2[0], v2[1], o.z, false); o.z = __builtin_amdgcn_cvt_pk_fp8_f32(v2[2], v2[3], o.z, true);
            o.w = __builtin_amdgcn_cvt_pk_fp8_f32(v3[0], v3[1], o.w, false); o.w = __builtin_amdgcn_cvt_pk_fp8_f32(v3[2], v3[3], o.w, true);
            *(u32x4*)(UQ + ((size_t)((g * 16 + sl) * 1024 + el)) * 128 + ((c ^ (el & 7)) * 16)) = o;
        }
    }
    __syncthreads();
    {
        const float* V = a.in[I_V]; unsigned char* VQ = ws + WS_VQ;
        for (int tile = bid; tile < 1024; tile += nb) {
            const int e0 = tile * 16;
#pragma unroll
            for (int i = 0; i < 8; ++i) { const int unit = tid + i * 512, e = unit >> 8, j8 = unit & 255;
                const f32x4 v0 = *(const f32x4*)(V + (size_t)(e0 + e) * D + j8 * 8), v1 = *(const f32x4*)(V + (size_t)(e0 + e) * D + j8 * 8 + 4);
                unsigned w0 = 0u, w1 = 0u;
                w0 = __builtin_amdgcn_cvt_pk_fp8_f32(v0[0], v0[1], w0, false); w0 = __builtin_amdgcn_cvt_pk_fp8_f32(v0[2], v0[3], w0, true);
                w1 = __builtin_amdgcn_cvt_pk_fp8_f32(v1[0], v1[1], w1, false); w1 = __builtin_amdgcn_cvt_pk_fp8_f32(v1[2], v1[3], w1, true);
                *(LAS u32x2*)(lds + e * 2056 + j8 * 8) = (u32x2){w0, w1}; }
            __syncthreads();
#pragma unroll
            for (int i = 0; i < 8; ++i) { const int unit = tid + i * 512, c = unit >> 4, e = unit & 15;
                *(u32x2*)(VQ + ((size_t)c * 16384 + e0 + e) * 8) = *(const LAS u32x2*)(lds + e * 2056 + c * 8); }
            __syncthreads();
        }
    }
    {
        const int* pos = (const int*)a.in[I_POS]; f32x2* rope = (f32x2*)(ws + WS_ROPE);
        for (int e = bid * 512 + tid; e < S * 8; e += nb * 512) {
            const int t = e >> 3, i = e & 7;
            const float invs[8] = {1.0f, 0.19392274474868576f, 0.03760603093086393f, 0.007292664737217109f, 0.001414213562373095f, 0.0002742481756762073f, 5.318295896944988e-05f, 1.031338537721246e-05f};
            float inv = invs[0];
#pragma unroll
            for (int j = 1; j < 8; ++j) inv = (i == j) ? invs[j] : inv;
            const float ang = (float)pos[t] * inv;
            float sn, cs; sincosf(ang, &sn, &cs);
            rope[e] = (f32x2){cs, sn};
        }
    }
}

__device__ __forceinline__ void phase1(const Args& a, int bid, int nb, int tid) {
    const float* modp = (const float*)(a.ws + WS_MODP); float* mod = (float*)(a.ws + WS_MOD); const float* b_ada = a.in[I_BADA];
    for (int n = bid * 512 + tid; n < 12288; n += nb * 512) { float s = b_ada[n];
#pragma unroll 8
        for (int k = 0; k < 32; ++k) s += modp[(size_t)k * 12288 + n];
        mod[n] = s; }
}

__device__ __forceinline__ void phase2(const Args& a, int bid, int nb, int tid) {
    const float* x = a.in[I_X]; const float* mod = (const float*)(a.ws + WS_MOD); bf16_t* H = (bf16_t*)(a.ws + WS_H);
    const size_t n8 = (size_t)S * D / 8, nthr = (size_t)nb * 512;
    for (size_t i = (size_t)bid * 512 + tid; i < n8; i += nthr) {
        const int col = (int)((i * 8) & (D - 1));
        const f32x4 v0 = *(const f32x4*)(x + i * 8), v1 = *(const f32x4*)(x + i * 8 + 4);
        const f32x4 sh0 = *(const f32x4*)(mod + col), sh1 = *(const f32x4*)(mod + col + 4), sc0 = *(const f32x4*)(mod + D + col), sc1 = *(const f32x4*)(mod + D + col + 4);
        const f32x4 h0 = v0 * (sc0 + 1.0f) + sh0, h1 = v1 * (sc1 + 1.0f) + sh1;
        u32x4 o; o.x = cvt_pk_bf16(h0[0], h0[1]); o.y = cvt_pk_bf16(h0[2], h0[3]); o.z = cvt_pk_bf16(h1[0], h1[1]); o.w = cvt_pk_bf16(h1[2], h1[3]);
        *(u32x4*)(H + i * 8) = o;
    }
}

__device__ __forceinline__ void rope16(u32x4& a, u32x4& b, const f32x2* rp) {
    float t1[8], t2[8];
    t1[0] = bf_lo(a.x); t1[1] = bf_hi(a.x); t1[2] = bf_lo(a.y); t1[3] = bf_hi(a.y); t1[4] = bf_lo(a.z); t1[5] = bf_hi(a.z); t1[6] = bf_lo(a.w); t1[7] = bf_hi(a.w);
    t2[0] = bf_lo(b.x); t2[1] = bf_hi(b.x); t2[2] = bf_lo(b.y); t2[3] = bf_hi(b.y); t2[4] = bf_lo(b.z); t2[5] = bf_hi(b.z); t2[6] = bf_lo(b.w); t2[7] = bf_hi(b.w);
    float o1[8], o2[8];
#pragma unroll
    for (int i = 0; i < 8; ++i) { const f32x2 cs = rp[i]; o1[i] = t1[i] * cs.x - t2[i] * cs.y; o2[i] = t2[i] * cs.x + t1[i] * cs.y; }
    a.x = cvt_pk_bf16(o1[0], o1[1]); a.y = cvt_pk_bf16(o1[2], o1[3]); a.z = cvt_pk_bf16(o1[4], o1[5]); a.w = cvt_pk_bf16(o1[6], o1[7]);
    b.x = cvt_pk_bf16(o2[0], o2[1]); b.y = cvt_pk_bf16(o2[2], o2[3]); b.z = cvt_pk_bf16(o2[4], o2[5]); b.w = cvt_pk_bf16(o2[6], o2[7]);
}

__device__ __forceinline__ void attn_item(const Args& a, LAS unsigned char* lds, int qb, int hd, int tid) {
    const bf16_t* PROJ = (const bf16_t*)(a.ws + WS_PROJ); const f32x2* ROPE = (const f32x2*)(a.ws + WS_ROPE); bf16_t* MIXIN = (bf16_t*)(a.ws + WS_MIXIN);
    LAS bf16_t* Ks = (LAS bf16_t*)lds;
    LAS bf16_t* Qs = Ks + 256 * 72;
    LAS bf16_t* Vt = Qs + 128 * 72;
    const int kvh = hd >> 3, t0 = qb * 128;
    {
        const int row = tid >> 2, q4 = tid & 3, tok = t0 + row;
        const bf16_t* src = PROJ + (size_t)tok * NINP + hd * 64 + q4 * 16;
        u32x4 x0 = *(const u32x4*)src, x1 = *(const u32x4*)(src + 8);
        if (q4 == 0) rope16(x0, x1, ROPE + tok * 8);
        *(LAS u32x4*)(Qs + row * 72 + q4 * 16) = x0; *(LAS u32x4*)(Qs + row * 72 + q4 * 16 + 8) = x1;
    }
#pragma unroll
    for (int i = 0; i < 2; ++i) {
        const int idx = tid + i * 512, row = idx >> 2, q4 = idx & 3, tok = t0 - 128 + row;
        u32x4 x0 = {0u, 0u, 0u, 0u}, x1 = {0u, 0u, 0u, 0u};
        if (tok >= 0) { const bf16_t* src = PROJ + (size_t)tok * NINP + 1024 + kvh * 64 + q4 * 16; x0 = *(const u32x4*)src; x1 = *(const u32x4*)(src + 8); if (q4 == 0) rope16(x0, x1, ROPE + tok * 8); }
        *(LAS u32x4*)(Ks + row * 72 + q4 * 16) = x0; *(LAS u32x4*)(Ks + row * 72 + q4 * 16 + 8) = x1;
    }
#pragma unroll
    for (int i = 0; i < 4; ++i) {
        const int idx = tid + i * 512, key = idx >> 3, ch = idx & 7, tok = t0 - 128 + key;
        u32x4 v = {0u, 0u, 0u, 0u};
        if (tok >= 0) v = *(const u32x4*)(PROJ + (size_t)tok * NINP + 1152 + kvh * 64 + ch * 8);
        LAS bf16_t* dst = Vt + (ch * 8) * 264 + key;
        dst[0 * 264] = (bf16_t)(v.x & 0xffffu); dst[1 * 264] = (bf16_t)(v.x >> 16); dst[2 * 264] = (bf16_t)(v.y & 0xffffu); dst[3 * 264] = (bf16_t)(v.y >> 16);
        dst[4 * 264] = (bf16_t)(v.z & 0xffffu); dst[5 * 264] = (bf16_t)(v.z >> 16); dst[6 * 264] = (bf16_t)(v.w & 0xffffu); dst[7 * 264] = (bf16_t)(v.w >> 16);
    }
    __syncthreads();
    const int w = tid >> 6, lane = tid & 63, fr = lane & 15, kq = lane >> 4;
    bf16x8 qf[2];
#pragma unroll
    for (int ks = 0; ks < 2; ++ks) qf[ks] = *(const LAS bf16x8*)(Qs + (16 * w + fr) * 72 + 32 * ks + 8 * kq);
    f32x4 s[16];
#pragma unroll
    for (int t = 0; t < 16; ++t) { s[t] = (f32x4){0.f, 0.f, 0.f, 0.f};
#pragma unroll
        for (int ks = 0; ks < 2; ++ks) { const bf16x8 kf = *(const LAS bf16x8*)(Ks + (16 * t + fr) * 72 + 32 * ks + 8 * kq); s[t] = __builtin_amdgcn_mfma_f32_16x16x32_bf16(kf, qf[ks], s[t], 0, 0, 0); } }
    const float sink = a.in[I_SINK][hd];
    const int qi = 16 * w + fr;
    float mx = sink;
#pragma unroll
    for (int t = 0; t < 16; ++t)
#pragma unroll
        for (int r = 0; r < 4; ++r) { const int j = 16 * t + 4 * kq + r; const bool valid = (j > qi) && (j <= qi + 128) && (qb > 0 || j >= 128);
            const float v = valid ? s[t][r] * 0.125f : -INFINITY; s[t][r] = v; mx = fmaxf(mx, v); }
    mx = fmaxf(mx, __shfl_xor(mx, 16)); mx = fmaxf(mx, __shfl_xor(mx, 32));
    float sum = 0.f;
#pragma unroll
    for (int t = 0; t < 16; ++t)
#pragma unroll
        for (int r = 0; r < 4; ++r) { const float p = __expf(s[t][r] - mx); s[t][r] = p; sum += p; }
    sum += __shfl_xor(sum, 16); sum += __shfl_xor(sum, 32);
    const float inv = 1.f / (sum + __expf(sink - mx));
    f32x4 o[4];
#pragma unroll
    for (int dt = 0; dt < 4; ++dt) o[dt] = (f32x4){0.f, 0.f, 0.f, 0.f};
#pragma unroll
    for (int u = 0; u < 8; ++u) {
        u32x4 pw; pw.x = cvt_pk_bf16(s[2 * u][0] * inv, s[2 * u][1] * inv); pw.y = cvt_pk_bf16(s[2 * u][2] * inv, s[2 * u][3] * inv);
        pw.z = cvt_pk_bf16(s[2 * u + 1][0] * inv, s[2 * u + 1][1] * inv); pw.w = cvt_pk_bf16(s[2 * u + 1][2] * inv, s[2 * u + 1][3] * inv);
        const bf16x8 pf = __builtin_bit_cast(bf16x8, pw);
#pragma unroll
        for (int dt = 0; dt < 4; ++dt) { const LAS bf16_t* vp = Vt + (16 * dt + fr) * 264 + 32 * u + 4 * kq;
            const u32x2 lo = *(const LAS u32x2*)vp, hi = *(const LAS u32x2*)(vp + 16);
            const u32x4 vw = {lo.x, lo.y, hi.x, hi.y};
            o[dt] = __builtin_amdgcn_mfma_f32_16x16x32_bf16(pf, __builtin_bit_cast(bf16x8, vw), o[dt], 0, 0, 0); }
    }
#pragma unroll
    for (int dt = 0; dt < 4; ++dt)
#pragma unroll
        for (int r = 0; r < 4; ++r) MIXIN[(size_t)(t0 + 16 * w + 4 * kq + r) * D + hd * 64 + 16 * dt + fr] = f2bf(o[dt][r]);
    __syncthreads();
}

__device__ __forceinline__ void ssda_item(const Args& a, LAS unsigned char* lds, int c, int h, int tid) {
    unsigned char* ws = a.ws;
    const bf16_t* PROJ = (const bf16_t*)(ws + WS_PROJ); const float* DT = (const float*)(ws + WS_DT); float* ACUM = (float*)(ws + WS_ACUM);
    bf16_t* XS = (bf16_t*)(ws + WS_XS); bf16_t* CPOST = (bf16_t*)(ws + WS_CPOST); float* YDIAG = (float*)(ws + WS_YDIAG); float* STATE = (float*)(ws + WS_STATE);
    LAS bf16_t* Bs = (LAS bf16_t*)lds;
    LAS bf16_t* BT = Bs + 128 * 136;
    LAS bf16_t* Cs = BT + 128 * 136;
    LAS bf16_t* XT = Cs + 128 * 136;
    LAS bf16_t* XDT = XT + 64 * 136;
    LAS float* dtS = (LAS float*)(XDT + 64 * 136);
    LAS float* acS = dtS + 128;
    const int g = h >> 3, tok0 = c * 128;
    const int w = tid >> 6, lane = tid & 63, fr = lane & 15, kq = lane >> 4;
    if (w == 0) {
        const float d0 = DT[(size_t)(tok0 + 2 * lane) * 16 + h], d1 = DT[(size_t)(tok0 + 2 * lane + 1) * 16 + h];
        const float A = -__expf(a.in[I_ALOG][h]);
        const float a0 = d0 * A, a1 = d1 * A;
        float sc = a0 + a1;
#pragma unroll
        for (int off = 1; off < 64; off <<= 1) { const float v = __shfl_up(sc, off); if (lane >= off) sc += v; }
        dtS[2 * lane] = d0; dtS[2 * lane + 1] = d1; acS[2 * lane] = sc - a1; acS[2 * lane + 1] = sc;
        ACUM[(size_t)(tok0 + 2 * lane) * 16 + h] = sc - a1; ACUM[(size_t)(tok0 + 2 * lane + 1) * 16 + h] = sc;
    }
    __syncthreads();
    const float acEnd = acS[127];
    const float* convw = a.in[I_CONVW]; const float* convb = a.in[I_CONVB];
    for (int i = 0; i < 5; ++i) {
        const int idx = tid + i * 512, cp = idx % 160, tg = idx / 160, ci = cp * 2;
        int xch; if (ci < 64) xch = h * 64 + ci; else if (ci < 192) xch = 1024 + g * 128 + (ci - 64); else xch = 1280 + g * 128 + (ci - 192);
        float w0[4], w1[4];
#pragma unroll
        for (int q = 0; q < 4; ++q) { w0[q] = convw[q * 1536 + xch]; w1[q] = convw[q * 1536 + xch + 1]; }
        const float b0 = convb[xch], b1 = convb[xch + 1];
        float r0[11], r1[11];
#pragma unroll
        for (int r = 0; r < 11; ++r) { const int tok = tok0 + tg * 8 - 3 + r; unsigned u = 0u; if (tok >= 0) u = *(const unsigned*)(PROJ + (size_t)tok * NINP + 2304 + xch); r0[r] = bf_lo(u); r1[r] = bf_hi(u); }
        float o0[8], o1[8];
#pragma unroll
        for (int j = 0; j < 8; ++j) { float v0 = b0, v1 = b1;
#pragma unroll
            for (int q = 0; q < 4; ++q) { v0 += w0[q] * r0[j + q]; v1 += w1[q] * r1[j + q]; }
            o0[j] = silu_f(v0); o1[j] = silu_f(v1); }
        const int l0 = tg * 8;
        if (ci < 64) {
            float x0[8], x1[8], y0[8], y1[8];
#pragma unroll
            for (int j = 0; j < 8; ++j) { const float dtv = dtS[l0 + j], dec = __expf(acEnd - acS[l0 + j]);
                *(unsigned*)(XS + (size_t)(tok0 + l0 + j) * 1024 + h * 64 + ci) = cvt_pk_bf16(o0[j], o1[j]);
                x0[j] = o0[j] * dtv; x1[j] = o1[j] * dtv; y0[j] = x0[j] * dec; y1[j] = x1[j] * dec; }
            u32x4 p; p.x = cvt_pk_bf16(x0[0], x0[1]); p.y = cvt_pk_bf16(x0[2], x0[3]); p.z = cvt_pk_bf16(x0[4], x0[5]); p.w = cvt_pk_bf16(x0[6], x0[7]); *(LAS u32x4*)(XT + ci * 136 + l0) = p;
            p.x = cvt_pk_bf16(x1[0], x1[1]); p.y = cvt_pk_bf16(x1[2], x1[3]); p.z = cvt_pk_bf16(x1[4], x1[5]); p.w = cvt_pk_bf16(x1[6], x1[7]); *(LAS u32x4*)(XT + (ci + 1) * 136 + l0) = p;
            p.x = cvt_pk_bf16(y0[0], y0[1]); p.y = cvt_pk_bf16(y0[2], y0[3]); p.z = cvt_pk_bf16(y0[4], y0[5]); p.w = cvt_pk_bf16(y0[6], y0[7]); *(LAS u32x4*)(XDT + ci * 136 + l0) = p;
            p.x = cvt_pk_bf16(y1[0], y1[1]); p.y = cvt_pk_bf16(y1[2], y1[3]); p.z = cvt_pk_bf16(y1[4], y1[5]); p.w = cvt_pk_bf16(y1[6], y1[7]); *(LAS u32x4*)(XDT + (ci + 1) * 136 + l0) = p;
        } else if (ci < 192) {
            const int n = ci - 64;
#pragma unroll
            for (int j = 0; j < 8; ++j) *(LAS unsigned*)(Bs + (l0 + j) * 136 + n) = cvt_pk_bf16(o0[j], o1[j]);
            u32x4 p; p.x = cvt_pk_bf16(o0[0], o0[1]); p.y = cvt_pk_bf16(o0[2], o0[3]); p.z = cvt_pk_bf16(o0[4], o0[5]); p.w = cvt_pk_bf16(o0[6], o0[7]); *(LAS u32x4*)(BT + n * 136 + l0) = p;
            p.x = cvt_pk_bf16(o1[0], o1[1]); p.y = cvt_pk_bf16(o1[2], o1[3]); p.z = cvt_pk_bf16(o1[4], o1[5]); p.w = cvt_pk_bf16(o1[6], o1[7]); *(LAS u32x4*)(BT + (n + 1) * 136 + l0) = p;
        } else {
            const int n = ci - 192;
#pragma unroll
            for (int j = 0; j < 8; ++j) { const unsigned pk = cvt_pk_bf16(o0[j], o1[j]); *(LAS unsigned*)(Cs + (l0 + j) * 136 + n) = pk;
                if ((h & 7) == 0) *(unsigned*)(CPOST + (size_t)(tok0 + l0 + j) * 256 + g * 128 + n) = pk; }
        }
    }
    __syncthreads();
    bf16x8 cf[4];
#pragma unroll
    for (int ks = 0; ks < 4; ++ks) cf[ks] = *(const LAS bf16x8*)(Cs + (16 * w + fr) * 136 + 32 * ks + 8 * kq);
    f32x4 s[8];
#pragma unroll
    for (int t = 0; t < 8; ++t) { s[t] = (f32x4){0.f, 0.f, 0.f, 0.f};
        if (t <= w) {
#pragma unroll
            for (int ks = 0; ks < 4; ++ks) { const bf16x8 bf = *(const LAS bf16x8*)(Bs + (16 * t + fr) * 136 + 32 * ks + 8 * kq); s[t] = __builtin_amdgcn_mfma_f32_16x16x32_bf16(bf, cf[ks], s[t], 0, 0, 0); } } }
    const int li = 16 * w + fr; const float al = acS[li];
#pragma unroll
    for (int t = 0; t < 8; ++t)
#pragma unroll
        for (int r = 0; r < 4; ++r) { const int si = 16 * t + 4 * kq + r; s[t][r] = (si <= li) ? s[t][r] * __expf(al - acS[si]) : 0.f; }
    f32x4 o[4];
#pragma unroll
    for (int pt = 0; pt < 4; ++pt) o[pt] = (f32x4){0.f, 0.f, 0.f, 0.f};
#pragma unroll
    for (int u = 0; u < 4; ++u) {
        if (2 * u <= w) {
            u32x4 pw; pw.x = cvt_pk_bf16(s[2 * u][0], s[2 * u][1]); pw.y = cvt_pk_bf16(s[2 * u][2], s[2 * u][3]); pw.z = cvt_pk_bf16(s[2 * u + 1][0], s[2 * u + 1][1]); pw.w = cvt_pk_bf16(s[2 * u + 1][2], s[2 * u + 1][3]);
            const bf16x8 pf = __builtin_bit_cast(bf16x8, pw);
#pragma unroll
            for (int pt = 0; pt < 4; ++pt) { const LAS bf16_t* xp = XT + (16 * pt + fr) * 136 + 32 * u + 4 * kq;
                const u32x2 lo = *(const LAS u32x2*)xp, hi = *(const LAS u32x2*)(xp + 16); const u32x4 vw = {lo.x, lo.y, hi.x, hi.y};
                o[pt] = __builtin_amdgcn_mfma_f32_16x16x32_bf16(pf, __builtin_bit_cast(bf16x8, vw), o[pt], 0, 0, 0); }
        }
    }
#pragma unroll
    for (int pt = 0; pt < 4; ++pt)
#pragma unroll
        for (int r = 0; r < 4; ++r) YDIAG[(size_t)(tok0 + 16 * w + 4 * kq + r) * 1024 + h * 64 + 16 * pt + fr] = o[pt][r];
#pragma unroll
    for (int pt = 0; pt < 4; ++pt) {
        f32x4 acc = {0.f, 0.f, 0.f, 0.f};
#pragma unroll
        for (int ks = 0; ks < 4; ++ks) { const bf16x8 af = *(const LAS bf16x8*)(XDT + (16 * pt + fr) * 136 + 32 * ks + 8 * kq); const bf16x8 bf = *(const LAS bf16x8*)(BT + (16 * w + fr) * 136 + 32 * ks + 8 * kq);
            acc = __builtin_amdgcn_mfma_f32_16x16x32_bf16(af, bf, acc, 0, 0, 0); }
#pragma unroll
        for (int r = 0; r < 4; ++r) STATE[((size_t)(c * 16 + h) * 64 + 16 * pt + 4 * kq + r) * 128 + 16 * w + fr] = acc[r];
    }
    __syncthreads();
}

__device__ __forceinline__ void phase5(const Args& a, int bid, int nb, int tid) {
    const float* STATE = (const float*)(a.ws + WS_STATE); const float* ACUM = (const float*)(a.ws + WS_ACUM); bf16_t* HIN = (bf16_t*)(a.ws + WS_HIN);
    for (int e = bid * 512 + tid; e < 16 * 64 * 128; e += nb * 512) {
        const int h = e >> 13; float hin = 0.f;
#pragma unroll 8
        for (int c = 0; c < 64; ++c) { const size_t off = (size_t)c * 131072 + e; HIN[off] = f2bf(hin);
            const float dec = __expf(ACUM[(size_t)(c * 128 + 127) * 16 + h]); hin = dec * hin + STATE[off]; }
    }
}

__device__ __forceinline__ void ssdb_item(const Args& a, LAS unsigned char* lds, int hc, int g, int tid) {
    unsigned char* ws = a.ws;
    const bf16_t* PROJ = (const bf16_t*)(ws + WS_PROJ); const float* ACUM = (const float*)(ws + WS_ACUM); const bf16_t* XS = (const bf16_t*)(ws + WS_XS);
    const bf16_t* CPOST = (const bf16_t*)(ws + WS_CPOST); const float* YDIAG = (const float*)(ws + WS_YDIAG); const bf16_t* HIN = (const bf16_t*)(ws + WS_HIN);
    bf16_t* MIXIN = (bf16_t*)(ws + WS_MIXIN);
    LAS float* ssq = (LAS float*)lds;
    const int w = tid >> 6, lane = tid & 63, fr = lane & 15, kq = lane >> 4;
    const int h = g * 8 + w, t0 = hc * 64, c = hc >> 1;
    f32x4 acc[4][4];
#pragma unroll
    for (int lt = 0; lt < 4; ++lt)
#pragma unroll
        for (int pt = 0; pt < 4; ++pt) acc[lt][pt] = (f32x4){0.f, 0.f, 0.f, 0.f};
    const bf16_t* hb = HIN + (size_t)(c * 16 + h) * 64 * 128;
#pragma unroll
    for (int ks = 0; ks < 4; ++ks) {
        bf16x8 cfr[4], hfr[4];
#pragma unroll
        for (int lt = 0; lt < 4; ++lt) cfr[lt] = *(const bf16x8*)(CPOST + (size_t)(t0 + 16 * lt + fr) * 256 + g * 128 + 32 * ks + 8 * kq);
#pragma unroll
        for (int pt = 0; pt < 4; ++pt) hfr[pt] = *(const bf16x8*)(hb + (size_t)(16 * pt + fr) * 128 + 32 * ks + 8 * kq);
#pragma unroll
        for (int lt = 0; lt < 4; ++lt)
#pragma unroll
            for (int pt = 0; pt < 4; ++pt) acc[lt][pt] = __builtin_amdgcn_mfma_f32_16x16x32_bf16(cfr[lt], hfr[pt], acc[lt][pt], 0, 0, 0);
    }
    const float dsk = a.in[I_DSKIP][h];
    float part[4][4];
#pragma unroll
    for (int lt = 0; lt < 4; ++lt)
#pragma unroll
        for (int r = 0; r < 4; ++r) {
            const int tok = t0 + 16 * lt + 4 * kq + r; const float ea = __expf(ACUM[(size_t)tok * 16 + h]); float sq = 0.f;
#pragma unroll
            for (int pt = 0; pt < 4; ++pt) { const int ch = h * 64 + 16 * pt + fr;
                const float xs = __uint_as_float((unsigned)XS[(size_t)tok * 1024 + ch] << 16); const float z = __uint_as_float((unsigned)PROJ[(size_t)tok * NINP + 1280 + ch] << 16);
                const float y = YDIAG[(size_t)tok * 1024 + ch] + acc[lt][pt][r] * ea + dsk * xs; const float gv = y * silu_f(z); acc[lt][pt][r] = gv; sq += gv * gv; }
            sq += __shfl_xor(sq, 1); sq += __shfl_xor(sq, 2); sq += __shfl_xor(sq, 4); sq += __shfl_xor(sq, 8);
            part[lt][r] = sq;
        }
    if (fr == 0) {
#pragma unroll
        for (int lt = 0; lt < 4; ++lt)
#pragma unroll
            for (int r = 0; r < 4; ++r) ssq[(16 * lt + 4 * kq + r) * 8 + w] = part[lt][r];
    }
    __syncthreads();
    const float* nw = a.in[I_NORMW];
#pragma unroll
    for (int lt = 0; lt < 4; ++lt)
#pragma unroll
        for (int r = 0; r < 4; ++r) {
            const int l = 16 * lt + 4 * kq + r; float tot = 0.f;
#pragma unroll
            for (int ww = 0; ww < 8; ++ww) tot += ssq[l * 8 + ww];
            const float rs = rsqrtf(tot * (1.f / 512.f) + LN_EPS);
#pragma unroll
            for (int pt = 0; pt < 4; ++pt) { const int ch = h * 64 + 16 * pt + fr; MIXIN[(size_t)(t0 + l) * D + 1024 + ch] = f2bf(acc[lt][pt][r] * rs * nw[ch]); }
        }
    __syncthreads();
}

__device__ __forceinline__ void phase8(const Args& a, int bid, int nb, int tid) {
    float* P = (float*)(a.ws + WS_PRE1); bf16_t* H = (bf16_t*)(a.ws + WS_H); const float* mod = (const float*)(a.ws + WS_MOD); unsigned char* H2Q = a.ws + WS_H2Q;
    const float* gam = a.in[I_LN1G]; const float* bet = a.in[I_LN1B];
    const int wave = tid >> 6, lane = tid & 63;
    for (int row = bid * 8 + wave; row < S; row += nb * 8) {
        float* pr = P + (size_t)row * D;
        f32x4 v[8]; float s = 0.f;
#pragma unroll
        for (int j = 0; j < 8; ++j) { v[j] = *(const f32x4*)(pr + 4 * lane + 256 * j); s += (v[j][0] + v[j][1]) + (v[j][2] + v[j][3]); }
        const float mean = wave_sum(s) * (1.f / D); float q = 0.f;
#pragma unroll
        for (int j = 0; j < 8; ++j) { v[j] = v[j] - mean; q += (v[j][0] * v[j][0] + v[j][1] * v[j][1]) + (v[j][2] * v[j][2] + v[j][3] * v[j][3]); }
        const float rstd = rsqrtf(wave_sum(q) * (1.f / D) + LN_EPS);
#pragma unroll
        for (int j = 0; j < 8; ++j) { const int col = 4 * lane + 256 * j;
            const f32x4 x1 = v[j] * rstd * *(const f32x4*)(gam + col) + *(const f32x4*)(bet + col);
            *(f32x4*)(pr + col) = x1;
            const f32x4 h2 = x1 * (*(const f32x4*)(mod + 4 * D + col) + 1.0f) + *(const f32x4*)(mod + 3 * D + col);
            u32x2 o; o.x = cvt_pk_bf16(h2[0], h2[1]); o.y = cvt_pk_bf16(h2[2], h2[3]);
            *(u32x2*)(H + (size_t)row * D + col) = o;
            unsigned q8 = 0u; q8 = __builtin_amdgcn_cvt_pk_fp8_f32(h2[0], h2[1], q8, false); q8 = __builtin_amdgcn_cvt_pk_fp8_f32(h2[2], h2[3], q8, true);
            *(unsigned*)(H2Q + (size_t)row * D + col) = q8; }
    }
}

template <int NV> __device__ __forceinline__ float topk_thresh(const float (&x)[NV]) {
    float mx = x[0], mn = x[0];
#pragma unroll
    for (int i = 1; i < NV; ++i) { mx = fmaxf(mx, x[i]); mn = fminf(mn, x[i]); }
    mx = wave_max(mx); mn = wave_min(mn);
    float lo = mn - 1.0f, hi = mx;
    for (int it = 0; it < 48; ++it) {
        const float mid = 0.5f * (lo + hi);
        int cnt = 0;
#pragma unroll
        for (int i = 0; i < NV; ++i) cnt += __popcll(__ballot(x[i] > mid));
        if (cnt == 16) { lo = mid; break; }
        if (cnt > 16) lo = mid; else hi = mid;
    }
    return lo;
}
__device__ __forceinline__ int lane_prefix(unsigned long long m) { return __builtin_amdgcn_mbcnt_hi((unsigned)(m >> 32), __builtin_amdgcn_mbcnt_lo((unsigned)m, 0u)); }

__device__ __forceinline__ void phase10(const Args& a, LAS unsigned char* lds, int bid, int nb, int tid) {
    const float* SC = (const float*)(a.ws + WS_PROJ); unsigned short* IDC = (unsigned short*)(a.ws + WS_IDC); unsigned short* TK = (unsigned short*)(a.ws + WS_TK); float* GATEC = (float*)(a.ws + WS_GATEC);
    unsigned short* LISTG = (unsigned short*)(a.ws + WS_LIST); int* OFFS = (int*)(a.ws + WS_OFFS); int* CNT = (int*)(a.ws + WS_OFFS + 65536);
    const int wave = tid >> 6, lane = tid & 63;
    LAS float* vs = (LAS float*)(lds + wave * 512);
    LAS int* is = (LAS int*)(lds + wave * 512 + 256);
    LAS int* tids = (LAS int*)(lds + 8192);
    LAS int* cnt = (LAS int*)(lds + 16384);
    LAS float* tgate = (LAS float*)(lds + 20480);
    for (int T = bid; T < 512; T += nb) {
        if (tid < 64) cnt[tid] = 0;
        for (int i = 0; i < 16; ++i) {
            const int it = wave * 16 + i, tcol = it >> 3, h = it & 7, tok = T * 16 + tcol;
            const float* sp = SC + (size_t)tok * D + h * 128;
#pragma unroll
            for (int half = 0; half < 2; ++half) {
                float x[2]; x[0] = sp[half * 1024 + lane]; x[1] = sp[half * 1024 + 64 + lane];
                const float lo = topk_thresh<2>(x);
                const unsigned long long m0 = __ballot(x[0] > lo), m1 = __ballot(x[1] > lo);
                const int p0 = lane_prefix(m0), p1 = __popcll(m0) + lane_prefix(m1);
                if (x[0] > lo && p0 < 16) { vs[half * 16 + p0] = x[0]; is[half * 16 + p0] = lane; }
                if (x[1] > lo && p1 < 16) { vs[half * 16 + p1] = x[1]; is[half * 16 + p1] = lane + 64; }
            }
            asm volatile("s_waitcnt lgkmcnt(0)" ::: "memory");
            const int ai = lane >> 2, b0 = (lane & 3) * 4;
            float cd[4]; const float va = vs[ai];
#pragma unroll
            for (int j = 0; j < 4; ++j) cd[j] = va + vs[16 + b0 + j];
            const float lo = topk_thresh<4>(cd);
            int base = 0;
#pragma unroll
            for (int j = 0; j < 4; ++j) { const unsigned long long m = __ballot(cd[j] > lo); const int p = base + lane_prefix(m);
                if (cd[j] > lo && p < 16) { vs[32 + p] = cd[j]; is[32 + p] = is[ai] * 128 + is[16 + b0 + j]; }
                base += __popcll(m); }
            asm volatile("s_waitcnt lgkmcnt(0)" ::: "memory");
            const float scv = vs[32 + (lane & 15)]; const int idv = is[32 + (lane & 15)];
            float m = scv; m = fmaxf(m, __shfl_xor(m, 1)); m = fmaxf(m, __shfl_xor(m, 2)); m = fmaxf(m, __shfl_xor(m, 4)); m = fmaxf(m, __shfl_xor(m, 8));
            const float e = __expf(scv - m); float sum = e; sum += __shfl_xor(sum, 1); sum += __shfl_xor(sum, 2); sum += __shfl_xor(sum, 4); sum += __shfl_xor(sum, 8);
            if (lane < 16) { tgate[tcol * 128 + h * 16 + lane] = e / sum; tids[tcol * 128 + h * 16 + lane] = idv; }
            asm volatile("s_waitcnt lgkmcnt(0)" ::: "memory");
        }
        __syncthreads();
#pragma unroll
        for (int q = 0; q < 4; ++q) { const int id = tids[tid + q * 512]; atomicAdd((int*)(cnt + (id >> 10)), 1); }
        __syncthreads();
        if (tid == 0) { int run = 0; for (int g = 0; g < 16; ++g) { cnt[64 + g] = run; run += cnt[g]; } cnt[64 + 16] = run; }
        __syncthreads();
#pragma unroll
        for (int q = 0; q < 4; ++q) { const int idx = tid + q * 512, id = tids[idx], g = id >> 10; const int i = atomicAdd((int*)(cnt + 32 + g), 1);
            if (i < 256) LISTG[((size_t)(g * 512 + T)) * 256 + (i & 15) * 16 + (i >> 4)] = (unsigned short)((id & 1023) | ((idx >> 7) << 10));
            const size_t cp = (size_t)T * 2048 + cnt[64 + g] + i;
            IDC[cp] = (unsigned short)id; TK[cp] = (unsigned short)idx; GATEC[cp] = tgate[idx]; }
        if (tid < 17) OFFS[T * 17 + tid] = cnt[64 + tid];
        if (tid < 16) CNT[tid * 512 + T] = min(cnt[tid], 256);
        __syncthreads();
    }
}

struct UStage { int n, off0; u32x4 e0, e1, h0, h1; };
#define U_LOAD(st, T_) do { const int T__ = (T_); \
    (st).n = CNT[g * 512 + T__]; (st).off0 = OFFS[T__ * 17 + g]; \
    const unsigned short* lp_ = LISTG + ((size_t)(g * 512 + T__)) * 256 + fr * 16; (st).e0 = *(const u32x4*)lp_; (st).e1 = *(const u32x4*)(lp_ + 8); \
    const unsigned char* hp_ = H2Q + (size_t)(T__ * 16 + fr) * D + sl * 128 + kq * 32; (st).h0 = *(const u32x4*)hp_; (st).h1 = *(const u32x4*)(hp_ + 16); } while (0)
#define U_SET(st, T_, s_, ew_) do { \
    const unsigned ent = ((ew_) >> (16 * ((s_) & 1))) & 0xffffu; const int eA = (int)(ent & 1023u), x_ = eA & 7; \
    const LAS unsigned char* rowp = lds + eA * 128; \
    const u32x4 b0 = *(const LAS u32x4*)(rowp + (((2 * kq) ^ x_) << 4)), b1 = *(const LAS u32x4*)(rowp + (((2 * kq + 1) ^ x_) << 4)); \
    f32x4 acc = {0.f, 0.f, 0.f, 0.f}; \
    acc = __builtin_amdgcn_mfma_f32_16x16x32_fp8_fp8(pk64((st).h0.x, (st).h0.y), pk64(b0.x, b0.y), acc, 0, 0, 0); \
    acc = __builtin_amdgcn_mfma_f32_16x16x32_fp8_fp8(pk64((st).h0.z, (st).h0.w), pk64(b0.z, b0.w), acc, 0, 0, 0); \
    acc = __builtin_amdgcn_mfma_f32_16x16x32_fp8_fp8(pk64((st).h1.x, (st).h1.y), pk64(b1.x, b1.y), acc, 0, 0, 0); \
    acc = __builtin_amdgcn_mfma_f32_16x16x32_fp8_fp8(pk64((st).h1.z, (st).h1.w), pk64(b1.z, b1.w), acc, 0, 0, 0); \
    const int tc = (int)(ent >> 10); const float v01 = (tc & 1) ? acc[1] : acc[0], v23 = (tc & 1) ? acc[3] : acc[2]; const float val = (tc & 2) ? v23 : v01; \
    if ((s_) * 16 + fr < nn && (tc >> 2) == kq) PART[((size_t)sl * 512 + (T_)) * 2048 + (st).off0 + (s_) * 16 + fr] = val * (1.0f / 64.0f); } while (0)
#define U_PROC(st, T_) do { const int nn = __builtin_amdgcn_readfirstlane((st).n); \
    if (nn > 0)   { U_SET(st, T_, 0, (st).e0.x);  } if (nn > 16)  { U_SET(st, T_, 1, (st).e0.x);  } if (nn > 32)  { U_SET(st, T_, 2, (st).e0.y);  } if (nn > 48)  { U_SET(st, T_, 3, (st).e0.y);  } \
    if (nn > 64)  { U_SET(st, T_, 4, (st).e0.z);  } if (nn > 80)  { U_SET(st, T_, 5, (st).e0.z);  } if (nn > 96)  { U_SET(st, T_, 6, (st).e0.w);  } if (nn > 112) { U_SET(st, T_, 7, (st).e0.w);  } \
    if (nn > 128) { U_SET(st, T_, 8, (st).e1.x);  } if (nn > 144) { U_SET(st, T_, 9, (st).e1.x);  } if (nn > 160) { U_SET(st, T_, 10, (st).e1.y); } if (nn > 176) { U_SET(st, T_, 11, (st).e1.y); } \
    if (nn > 192) { U_SET(st, T_, 12, (st).e1.z); } if (nn > 208) { U_SET(st, T_, 13, (st).e1.z); } if (nn > 224) { U_SET(st, T_, 14, (st).e1.w); } if (nn > 240) { U_SET(st, T_, 15, (st).e1.w); } } while (0)
__device__ __forceinline__ long pk64(unsigned lo, unsigned hi) { return (long)(((unsigned long long)hi << 32) | (unsigned long long)lo); }

__device__ __forceinline__ void phase11(const Args& a, LAS unsigned char* lds, int bid, int nb, int tid) {
    unsigned char* ws = a.ws;
    const unsigned char* H2Q = ws + WS_H2Q; const unsigned char* UQ = ws + WS_UQ; const unsigned short* LISTG = (const unsigned short*)(ws + WS_LIST);
    const int* OFFS = (const int*)(ws + WS_OFFS); const int* CNT = (const int*)(ws + WS_OFFS + 65536);
    float* PART = (float*)(ws + WS_PART);
    const int w = tid >> 6, lane = tid & 63, fr = lane & 15, kq = lane >> 4;
    for (int item = bid; item < 256; item += nb) {
        const int g = item >> 4, sl = item & 15;
        {
            const unsigned char* src = UQ + (size_t)item * 131072;
#pragma unroll
            for (int i = 0; i < 16; ++i) { const int off = (tid + i * 512) * 16; *(LAS u32x4*)(lds + off) = *(const u32x4*)(src + off); }
        }
        __syncthreads();
        UStage sA, sB, sC, sD;
        U_LOAD(sA, w); U_LOAD(sB, w + 8); U_LOAD(sC, w + 16); U_LOAD(sD, w + 24);
        for (int T = w; T < 512; T += 32) {
            U_PROC(sA, T);      if (T + 32 < 512) U_LOAD(sA, T + 32);
            U_PROC(sB, T + 8);  if (T + 40 < 512) U_LOAD(sB, T + 40);
            U_PROC(sC, T + 16); if (T + 48 < 512) U_LOAD(sC, T + 48);
            U_PROC(sD, T + 24); if (T + 56 < 512) U_LOAD(sD, T + 56);
        }
        __syncthreads();
    }
}

__device__ __forceinline__ void phase12(const Args& a, LAS unsigned char* lds, int bid, int nb, int tid) {
    unsigned char* ws = a.ws;
    const float* PART = (const float*)(ws + WS_PART); const unsigned short* IDC = (const unsigned short*)(ws + WS_IDC); const unsigned short* TK = (const unsigned short*)(ws + WS_TK);
    const float* GATEC = (const float*)(ws + WS_GATEC); const int* OFFS = (const int*)(ws + WS_OFFS); unsigned* PAIRV = (unsigned*)(ws + WS_PAIRV);
    const bf16_t* H2 = (const bf16_t*)(ws + WS_H); const float* U = a.in[I_U];
    LAS unsigned* tile = (LAS unsigned*)lds;
    for (int T = bid; T < 512; T += nb) {
        const size_t base = (size_t)T * 2048 + tid * 4;
        f32x4 s0 = {0.f, 0.f, 0.f, 0.f};
#pragma unroll
        for (int sl = 0; sl < 16; ++sl) s0 += *(const f32x4*)(PART + (size_t)sl * 512 * 2048 + base);
        const u32x2 iw = *(const u32x2*)(IDC + base), tw = *(const u32x2*)(TK + base); const f32x4 gt = *(const f32x4*)(GATEC + base);
        int id[4], tk[4]; id[0] = iw.x & 0xffff; id[1] = iw.x >> 16; id[2] = iw.y & 0xffff; id[3] = iw.y >> 16; tk[0] = tw.x & 0xffff; tk[1] = tw.x >> 16; tk[2] = tw.y & 0xffff; tk[3] = tw.y >> 16;
#pragma unroll
        for (int j = 0; j < 4; ++j) {
            float act = s0[j];
            if (tid * 4 + j - OFFS[T * 17 + (id[j] >> 10)] >= 256) {
                const bf16_t* hp = H2 + (size_t)(T * 16 + (tk[j] >> 7)) * D; const float* up = U + (size_t)id[j] * D; act = 0.f;
                for (int d = 0; d < D; ++d) act += __uint_as_float((unsigned)hp[d] << 16) * up[d];
            }
            tile[(tk[j] & 127) * 17 + (tk[j] >> 7)] = (unsigned)id[j] | (cvt_pk_bf16(0.f, gt[j] * gelu_erf(act)) & 0xffff0000u);
        }
        __syncthreads();
#pragma unroll
        for (int q = 0; q < 4; ++q) { const int idx = tid + q * 512, k = idx >> 4, tt = idx & 15; PAIRV[(size_t)k * S + T * 16 + tt] = tile[k * 17 + tt]; }
        __syncthreads();
    }
}

__device__ __forceinline__ void phase13(const Args& a, LAS unsigned char* lds, int bid, int nb, int tid) {
    unsigned char* ws = a.ws;
    const unsigned* PAIRV = (const unsigned*)(ws + WS_PAIRV); const unsigned char* VQ = ws + WS_VQ; bf16_t* FFNT = (bf16_t*)(ws + WS_FFNT);
    const int w = tid >> 6, lane = tid & 63;
    for (int c = bid; c < 256; c += nb) {
        {
            const unsigned char* src = VQ + (size_t)c * 131072;
#pragma unroll
            for (int i = 0; i < 16; ++i) { const int off = (tid + i * 512) * 16; *(LAS u32x4*)(lds + off) = *(const u32x4*)(src + off); }
        }
        __syncthreads();
        for (int task = w; task < 32; task += 8) {
            const int t4 = task * 256 + lane * 4;
            f32x2 acc[4][4];
#pragma unroll
            for (int q = 0; q < 4; ++q)
#pragma unroll
                for (int j = 0; j < 4; ++j) acc[q][j] = (f32x2){0.f, 0.f};
            const unsigned* pp = PAIRV + t4;
            u32x4 pr[8];
#pragma unroll
            for (int j = 0; j < 8; ++j) pr[j] = *(const u32x4*)(pp + (size_t)j * S);
            for (int kb = 0; kb < 16; ++kb) {
                u32x4 nx[8];
                const int kn = (kb < 15 ? kb + 1 : kb) * 8;
#pragma unroll
                for (int j = 0; j < 8; ++j) nx[j] = *(const u32x4*)(pp + (size_t)(kn + j) * S);
                u32x2 vv[2][4];
#pragma unroll
                for (int q = 0; q < 4; ++q) vv[0][q] = *(const LAS u32x2*)(lds + ((pr[0][q] & 0xffffu) << 3));
#pragma unroll
                for (int j = 0; j < 8; ++j) {
                    if (j < 7) {
#pragma unroll
                        for (int q = 0; q < 4; ++q) vv[(j + 1) & 1][q] = *(const LAS u32x2*)(lds + ((pr[j + 1][q] & 0xffffu) << 3));
                    }
#pragma unroll
                    for (int q = 0; q < 4; ++q) {
                        const float coef = __uint_as_float(pr[j][q] & 0xffff0000u); const u32x2 v = vv[j & 1][q];
                        acc[q][0] += __builtin_amdgcn_cvt_pk_f32_fp8((int)v.x, false) * coef; acc[q][1] += __builtin_amdgcn_cvt_pk_f32_fp8((int)v.x, true) * coef;
                        acc[q][2] += __builtin_amdgcn_cvt_pk_f32_fp8((int)v.y, false) * coef; acc[q][3] += __builtin_amdgcn_cvt_pk_f32_fp8((int)v.y, true) * coef;
                    }
                }
#pragma unroll
                for (int j = 0; j < 8; ++j) pr[j] = nx[j];
            }
#pragma unroll
            for (int q = 0; q < 4; ++q) { u32x4 o; o.x = cvt_pk_bf16(acc[q][0].x, acc[q][0].y); o.y = cvt_pk_bf16(acc[q][1].x, acc[q][1].y); o.z = cvt_pk_bf16(acc[q][2].x, acc[q][2].y); o.w = cvt_pk_bf16(acc[q][3].x, acc[q][3].y);
                *(u32x4*)(FFNT + ((size_t)c * S + t4 + q) * 8) = o; }
        }
        __syncthreads();
    }
}

__device__ __forceinline__ void phase14(const Args& a, int bid, int nb, int tid) {
    unsigned char* ws = a.ws;
    const float* X1 = (const float*)(ws + WS_PRE1); const bf16_t* FFNT = (const bf16_t*)(ws + WS_FFNT); const float* mod = (const float*)(ws + WS_MOD);
    const float* gam = a.in[I_LN2G]; const float* bet = a.in[I_LN2B]; float* out = a.out;
    const int wave = tid >> 6, lane = tid & 63;
    for (int tok = bid * 8 + wave; tok < S; tok += nb * 8) {
        float acc[32];
#pragma unroll
        for (int j = 0; j < 4; ++j) { const u32x4 v = *(const u32x4*)(FFNT + ((size_t)(lane + 64 * j) * S + tok) * 8);
            acc[8 * j + 0] = bf_lo(v.x); acc[8 * j + 1] = bf_hi(v.x); acc[8 * j + 2] = bf_lo(v.y); acc[8 * j + 3] = bf_hi(v.y); acc[8 * j + 4] = bf_lo(v.z); acc[8 * j + 5] = bf_hi(v.z); acc[8 * j + 6] = bf_lo(v.w); acc[8 * j + 7] = bf_hi(v.w); }
        float s = 0.f;
#pragma unroll
        for (int j = 0; j < 4; ++j) { const int col = 8 * lane + 512 * j;
            const f32x4 xa = *(const f32x4*)(X1 + (size_t)tok * D + col), xb = *(const f32x4*)(X1 + (size_t)tok * D + col + 4);
            const f32x4 ga = *(const f32x4*)(mod + 5 * D + col), gb = *(const f32x4*)(mod + 5 * D + col + 4);
#pragma unroll
            for (int i = 0; i < 4; ++i) { acc[8 * j + i] = ALPHA * xa[i] + (1.f + ga[i]) * acc[8 * j + i]; acc[8 * j + 4 + i] = ALPHA * xb[i] + (1.f + gb[i]) * acc[8 * j + 4 + i]; }
#pragma unroll
            for (int i = 0; i < 8; ++i) s += acc[8 * j + i]; }
        const float mean = wave_sum(s) * (1.f / D); float q = 0.f;
#pragma unroll
        for (int i = 0; i < 32; ++i) { acc[i] -= mean; q += acc[i] * acc[i]; }
        const float rstd = rsqrtf(wave_sum(q) * (1.f / D) + LN_EPS);
#pragma unroll
        for (int j = 0; j < 4; ++j) { const int col = 8 * lane + 512 * j;
            const f32x4 ga = *(const f32x4*)(gam + col), gb = *(const f32x4*)(gam + col + 4), ba = *(const f32x4*)(bet + col), bb = *(const f32x4*)(bet + col + 4);
            f32x4 oa, ob;
#pragma unroll
            for (int i = 0; i < 4; ++i) { oa[i] = acc[8 * j + i] * rstd * ga[i] + ba[i]; ob[i] = acc[8 * j + 4 + i] * rstd * gb[i] + bb[i]; }
            *(f32x4*)(out + (size_t)tok * D + col) = oa; *(f32x4*)(out + (size_t)tok * D + col + 4) = ob; }
    }
}

__global__ void __launch_bounds__(512, 2) mega(Args args) {
    extern __shared__ __attribute__((aligned(16))) unsigned char lds_raw[];
    LAS unsigned char* lds = (LAS unsigned char*)lds_raw;
    const int tid = threadIdx.x, bid = blockIdx.x, nb = gridDim.x;
    const int lo = args.ph_lo, hi = args.ph_hi;
    unsigned char* ws = args.ws;
    volatile LAS unsigned* MISC = (volatile LAS unsigned*)(lds + LDS_BYTES - 64);
    XcdBarrier bar; bar.bar = (unsigned*)(ws + WS_CTL); bar.x = 0; bar.st = nullptr;
    if (hi - lo > 1) {
        if (tid < 16) MISC[tid] = 0u;
        __syncthreads();
        bar = xcd_barrier_post((unsigned*)(ws + WS_CTL), MISC + 8);
    }
#define IN(k) (lo <= (k) && (k) < hi)
#define SEAM(k) do { if (IN(k) && IN((k) + 1)) xcd_barrier(bar); } while (0)
    if (IN(0)) { phase0(args, lds, bid, nb, tid); } SEAM(0);
    if (IN(1)) { phase1(args, bid, nb, tid); } SEAM(1);
    if (IN(2)) { phase2(args, bid, nb, tid); } SEAM(2);
    if (IN(3)) {
        pg8::Gemm g{(const bf16_t*)(ws + WS_H), (const bf16_t*)(ws + WS_WIN), S, NINP, D}; pg8::StaticOrder so; so.init(S, NINP, nb, bid);
        pg8::EpiProj E{(bf16_t*)(ws + WS_PROJ), (float*)(ws + WS_DT), args.in[I_DTB]};
        pg8::gemm_phase<pg8::EpiProj, pg8::StaticOrder, true, true>(lds, g, so, E);
    } SEAM(3);
    if (IN(4)) {
        for (int item = bid; item < 2048; item += nb) {
            if (item < 1024) ssda_item(args, lds, item >> 4, item & 15, tid);
            else attn_item(args, lds, (item - 1024) >> 4, (item - 1024) & 15, tid);
        }
    } SEAM(4);
    if (IN(5)) { phase5(args, bid, nb, tid); } SEAM(5);
    if (IN(6)) { for (int item = bid; item < 256; item += nb) ssdb_item(args, lds, item >> 1, item & 1, tid); } SEAM(6);
    if (IN(7)) {
        pg8::Gemm g{(const bf16_t*)(ws + WS_MIXIN), (const bf16_t*)(ws + WS_WOUT), S, D, D}; pg8::StaticOrder so; so.init(S, D, nb, bid);
        pg8::EpiPre1 E{args.in[I_X], (const float*)(ws + WS_MOD) + 2 * D, (float*)(ws + WS_PRE1)};
        pg8::gemm_phase<pg8::EpiPre1, pg8::StaticOrder, true, true>(lds, g, so, E);
    } SEAM(7);
    if (IN(8)) { phase8(args, bid, nb, tid); } SEAM(8);
    if (IN(9)) {
        pg8::Gemm g{(const bf16_t*)(ws + WS_H), (const bf16_t*)(ws + WS_WSC), S, D, D}; pg8::StaticOrder so; so.init(S, D, nb, bid);
        pg8::EpiF32 E{(float*)(ws + WS_PROJ), D};
        pg8::gemm_phase<pg8::EpiF32, pg8::StaticOrder, true, true>(lds, g, so, E);
    } SEAM(9);
    if (IN(10)) { phase10(args, lds, bid, nb, tid); } SEAM(10);
    if (IN(11)) { phase11(args, lds, bid, nb, tid); } SEAM(11);
    if (IN(12)) { phase12(args, lds, bid, nb, tid); } SEAM(12);
    if (IN(13)) { phase13(args, lds, bid, nb, tid); } SEAM(13);
    if (IN(14)) { phase14(args, bid, nb, tid); }
#undef IN
#undef SEAM
}

extern "C" void kernel_launch(void* const* d_in, const int* in_sizes, int n_in, void* d_out, int out_size, void* d_ws, size_t ws_size, hipStream_t stream) {
    static int grid = 0;
    if (grid == 0) {
        if (n_in != 23 || in_sizes[0] != S * D || out_size != S * D || ws_size < WS_END) { fprintf(stderr, "kernel_launch: unexpected shapes (n_in %d, in0 %d, out %d, ws %zu)\n", n_in, n_in > 0 ? in_sizes[0] : -1, out_size, ws_size); grid = -1; return; }
        int dev = 0, cus = 0, per_cu = 0;
        if (hipGetDevice(&dev) != hipSuccess || hipDeviceGetAttribute(&cus, hipDeviceAttributeMultiprocessorCount, dev) != hipSuccess) { grid = -1; return; }
        if (hipFuncSetAttribute((const void*)mega, hipFuncAttributeMaxDynamicSharedMemorySize, LDS_BYTES) != hipSuccess) { fprintf(stderr, "kernel_launch: hipFuncSetAttribute failed\n"); grid = -1; return; }
        if (hipOccupancyMaxActiveBlocksPerMultiprocessor(&per_cu, (const void*)mega, 512, LDS_BYTES) != hipSuccess || per_cu < 1) { fprintf(stderr, "kernel_launch: occupancy query says %d blocks/CU\n", per_cu); (void)hipGetLastError(); grid = -1; return; }
        grid = cus;
    }
    if (grid < 0) return;
    (void)hipMemsetAsync((char*)d_ws + WS_CTL, 0, CTL_ZERO_BYTES, stream);
    Args a{};
    for (int i = 0; i < 23; ++i) a.in[i] = (const float*)d_in[i];
    a.out = (float*)d_out; a.ws = (unsigned char*)d_ws;
    constexpr int NL = MK_N_LAUNCHES;
    for (int li = 0; li < NL; ++li) {
        a.ph_lo = (NL == NPH) ? li : (li * NPH) / NL; a.ph_hi = (NL == NPH) ? li + 1 : ((li + 1) * NPH) / NL;
        hipLaunchKernelGGL(mega, dim3(grid), dim3(512), LDS_BYTES, stream, a);
    }
}
```

```cpp
#include <hip/hip_runtime.h>
#include <cstdio>
#include <cstdint>

#ifndef MK_N_LAUNCHES
#define MK_N_LAUNCHES 1
#endif

#define LAS __attribute__((address_space(3)))
#define GAS __attribute__((address_space(1)))
typedef unsigned short bf16_t;
typedef short bf16x8 __attribute__((ext_vector_type(8)));
typedef float f32x4 __attribute__((ext_vector_type(4)));
typedef float f32x2 __attribute__((ext_vector_type(2)));
typedef unsigned u32x4 __attribute__((ext_vector_type(4)));
typedef unsigned u32x2 __attribute__((ext_vector_type(2)));

constexpr int S = 8192, D = 2048, NIN = 3856, NINP = 4096;
constexpr int NPH = 15;
constexpr float ALPHA = 1.189207115002721f;
constexpr float LN_EPS = 1e-5f;

constexpr size_t MiB = 1u << 20;
constexpr size_t WS_CTL = 0, CTL_ZERO_BYTES = 64 * 1024;
constexpr size_t WS_MODP = 1 * MiB;
constexpr size_t WS_MOD = 3 * MiB;
constexpr size_t WS_ROPE = 3 * MiB + 512 * 1024;
constexpr size_t WS_WIN = 4 * MiB;
constexpr size_t WS_WOUT = 20 * MiB;
constexpr size_t WS_WSC = 28 * MiB;
constexpr size_t WS_H = 36 * MiB;
constexpr size_t WS_PROJ = 68 * MiB;
constexpr size_t WS_DT = 132 * MiB;
constexpr size_t WS_ACUM = 132 * MiB + 512 * 1024;
constexpr size_t WS_XS = 133 * MiB;
constexpr size_t WS_CPOST = 149 * MiB;
constexpr size_t WS_YDIAG = 153 * MiB;
constexpr size_t WS_STATE = 185 * MiB;
constexpr size_t WS_HIN = 217 * MiB;
constexpr size_t WS_MIXIN = 233 * MiB;
constexpr size_t WS_PRE1 = 265 * MiB;
constexpr size_t WS_IDC = 329 * MiB;
constexpr size_t WS_TK = 331 * MiB;
constexpr size_t WS_GATEC = 333 * MiB;
constexpr size_t WS_UQ = 340 * MiB;
constexpr size_t WS_H2Q = 372 * MiB;
constexpr size_t WS_VQ = 404 * MiB;
constexpr size_t WS_LIST = 448 * MiB;
constexpr size_t WS_TRASH = 436 * MiB;
constexpr size_t WS_OFFS = 440 * MiB;
constexpr size_t WS_PAIRV = 443 * MiB;
constexpr size_t WS_PART = WS_PROJ;
constexpr size_t WS_FFNT = WS_YDIAG;
constexpr size_t WS_END = 480 * MiB;

constexpr int LDS_BYTES = 147456;

__device__ __forceinline__ unsigned cvt_pk_bf16(float lo, float hi) { unsigned r; asm volatile("v_cvt_pk_bf16_f32 %0, %1, %2" : "=v"(r) : "v"(lo), "v"(hi)); return r; }
__device__ __forceinline__ float bf_lo(unsigned u) { return __uint_as_float(u << 16); }
__device__ __forceinline__ float bf_hi(unsigned u) { return __uint_as_float(u & 0xffff0000u); }
__device__ __forceinline__ bf16_t f2bf(float f) { return (bf16_t)(cvt_pk_bf16(f, 0.f) & 0xffffu); }
__device__ __forceinline__ float wave_sum(float v) {
#pragma unroll
    for (int o = 1; o < 64; o <<= 1) v += __shfl_xor(v, o);
    return v;
}
__device__ __forceinline__ float wave_max(float v) {
#pragma unroll
    for (int o = 1; o < 64; o <<= 1) v = fmaxf(v, __shfl_xor(v, o));
    return v;
}
__device__ __forceinline__ float wave_min(float v) {
#pragma unroll
    for (int o = 1; o < 64; o <<= 1) v = fminf(v, __shfl_xor(v, o));
    return v;
}
__device__ __forceinline__ float silu_f(float v) { return v / (1.f + __expf(-v)); }
__device__ __forceinline__ float softplus_f(float v) { return v > 20.f ? v : log1pf(__expf(v)); }
__device__ __forceinline__ float gelu_erf(float v) { return 0.5f * v * (1.f + erff(v * 0.70710678118654752f)); }

namespace pg8 {
constexpr int BM = 256, BK = 64, HALF = 128, HTB = HALF * BK * 2, STAGE_BYTES = 8 * HTB, NXCD = 8, WGM = 8;
__host__ __device__ __forceinline__ int lds_byte(int r, int c) { const int st = (r >> 4) * 2 + (c >> 5), rr = r & 15, cc = c & 31, ob = rr * 64 + cc * 2; return st * 1024 + (ob ^ (((ob >> 9) & 1) << 5)); }
__host__ __device__ __forceinline__ void stage_rc(int b, int& R, int& C) { const int st = b / 1024, sb = b % 1024, swz = sb ^ (((sb >> 9) & 1) << 5); R = (st >> 1) * 16 + swz / 64; C = (st & 1) * 32 + (swz % 64) / 2; }
__host__ __device__ __forceinline__ int perm32(int rho) { const int n = rho >> 4, i = rho & 15; return 8 * (i >> 2) + 4 * n + (i & 3); }

struct Unit { int pm, pn; };
struct Gemm { const bf16_t* A; const bf16_t* Bt; int M, N, K; };

struct StaticOrder {
    int nM, nN, nwg, G, c;
    __host__ __device__ void init(int M, int N, int G_, int c_) { nM = M / BM; nN = N / BM; nwg = nM * nN; G = G_; c = c_; }
    __host__ __device__ bool next(int i, Unit& u) const {
        const long L = (long)i * G + c; if (L >= nwg) return false;
        int wgid = (int)L; { const int q = nwg / NXCD, r = nwg % NXCD, xcd = wgid % NXCD, off = wgid / NXCD; wgid = (xcd < r ? xcd * (q + 1) : r * (q + 1) + (xcd - r) * q) + off; }
        const int nig = WGM * nN, gid = wgid / nig, fm = gid * WGM, gsz = (nM - fm) < WGM ? (nM - fm) : WGM;
        u.pm = fm + ((wgid % nig) % gsz); u.pn = (wgid % nig) / gsz; return true;
    }
    __device__ __forceinline__ void a_ready(const Unit&) const {}
    __device__ __forceinline__ void done(const Unit&) const {}
};

struct EpiProj {
    static constexpr bool PERM = true, AFTER_DRAIN = false;
    bf16_t* O; float* DT; const float* dt_bias;
    __device__ __forceinline__ void operator()(const f32x4 (&acc)[2][2][4][2], const Unit& u, int wr, int wc, int fr, int fq) const {
        const int row0 = u.pm * BM + wr * 64 + fr; const int col0 = u.pn * BM + wc * 32 + 8 * fq;
#pragma unroll
        for (int ai = 0; ai < 2; ++ai)
#pragma unroll
            for (int m = 0; m < 4; ++m) { bf16_t* rowp = O + (size_t)(row0 + ai * HALF + m * 16) * NINP + col0;
#pragma unroll
                for (int bj = 0; bj < 2; ++bj) { const f32x4 v0 = acc[ai][bj][m][0], v1 = acc[ai][bj][m][1];
                    u32x4 w; w.x = cvt_pk_bf16(v0[0], v0[1]); w.y = cvt_pk_bf16(v0[2], v0[3]); w.z = cvt_pk_bf16(v1[0], v1[1]); w.w = cvt_pk_bf16(v1[2], v1[3]);
                    *(u32x4*)(rowp + bj * HALF) = w; } }
        if (u.pn == 15 && wc == 0 && fq < 2) {
            float bias[8];
#pragma unroll
            for (int i = 0; i < 8; ++i) bias[i] = dt_bias[8 * fq + i];
#pragma unroll
            for (int ai = 0; ai < 2; ++ai)
#pragma unroll
                for (int m = 0; m < 4; ++m) { float* dp = DT + (size_t)(row0 + ai * HALF + m * 16) * 16 + 8 * fq; const f32x4 v0 = acc[ai][0][m][0], v1 = acc[ai][0][m][1];
                    f32x4 o0, o1;
#pragma unroll
                    for (int i = 0; i < 4; ++i) { o0[i] = softplus_f(v0[i] + bias[i]); o1[i] = softplus_f(v1[i] + bias[4 + i]); }
                    *(f32x4*)dp = o0; *(f32x4*)(dp + 4) = o1; }
        }
    }
};
struct EpiPre1 {
    static constexpr bool PERM = false, AFTER_DRAIN = false;
    const float* X; const float* g1; float* O;
    __device__ __forceinline__ void operator()(const f32x4 (&acc)[2][2][4][2], const Unit& u, int wr, int wc, int fr, int fq) const {
        const int row0 = u.pm * BM + wr * 64 + fr; const int col0 = u.pn * BM + wc * 32 + 4 * fq;
        f32x4 gv[2][2];
#pragma unroll
        for (int bj = 0; bj < 2; ++bj)
#pragma unroll
            for (int n = 0; n < 2; ++n) gv[bj][n] = *(const f32x4*)(g1 + col0 + bj * HALF + n * 16) + 1.0f;
#pragma unroll
        for (int ai = 0; ai < 2; ++ai)
#pragma unroll
            for (int m = 0; m < 4; ++m) { const size_t off = (size_t)(row0 + ai * HALF + m * 16) * D + col0;
#pragma unroll
                for (int bj = 0; bj < 2; ++bj)
#pragma unroll
                    for (int n = 0; n < 2; ++n) { const f32x4 xv = *(const f32x4*)(X + off + bj * HALF + n * 16);
                        *(f32x4*)(O + off + bj * HALF + n * 16) = xv * ALPHA + gv[bj][n] * acc[ai][bj][m][n]; } }
    }
};
struct EpiF32 {
    static constexpr bool PERM = false, AFTER_DRAIN = false;
    float* O; int ldc;
    __device__ __forceinline__ void operator()(const f32x4 (&acc)[2][2][4][2], const Unit& u, int wr, int wc, int fr, int fq) const {
        const int row0 = u.pm * BM + wr * 64 + fr; const int col0 = u.pn * BM + wc * 32 + 4 * fq;
#pragma unroll
        for (int ai = 0; ai < 2; ++ai)
#pragma unroll
            for (int m = 0; m < 4; ++m) { const size_t off = (size_t)(row0 + ai * HALF + m * 16) * ldc + col0;
#pragma unroll
                for (int bj = 0; bj < 2; ++bj)
#pragma unroll
                    for (int n = 0; n < 2; ++n) *(f32x4*)(O + off + bj * HALF + n * 16) = acc[ai][bj][m][n]; }
    }
};

template <class Epi, class Sched, bool ALIGN_EPI = false, bool SP2 = false>
__device__ __forceinline__ void gemm_phase(LAS unsigned char* lds, const Gemm g, const Sched& S, const Epi& E) {
    const int tid = threadIdx.x, wid = __builtin_amdgcn_readfirstlane(tid >> 6), lane = tid & 63, wr = wid >> 2, wc = wid & 3, fr = lane & 15, fq = lane >> 4;
    const int K = g.K, nt = K / BK;
    unsigned voffA[2], voffB[2];
#pragma unroll
    for (int i = 0; i < 2; ++i) { int R, C; stage_rc(tid * 16 + i * 8192, R, C); const int Rb = Epi::PERM ? ((R & ~31) + perm32(R & 31)) : R;
        voffA[i] = (unsigned)(R * K + C) * 2u; voffB[i] = (unsigned)(Rb * K + C) * 2u; }
    const size_t kstep = (size_t)(BK * 2);
    const size_t hstep = (size_t)HALF * K * 2;
    const size_t tstep = 2 * hstep;
    const unsigned ldsw = (unsigned)wid * 1024u;
    const int aoff = lds_byte(wr * 64 + fr, fq * 8), boff = lds_byte(wc * 32 + fr, fq * 8);
#define PG8_SA(b, h) (((b) * 2 + (h)) * HTB)
#define PG8_SB(b, h) ((4 + (b) * 2 + (h)) * HTB)
#define PG8_STAGE(bufoff, gbase, voff) do { _Pragma("unroll") for (int _i = 0; _i < 2; ++_i) \
        __builtin_amdgcn_global_load_lds((const unsigned*)((const char*)(gbase) + (voff)[_i]), (LAS unsigned*)(lds + (bufoff) + ldsw + _i * 8192), 16, 0, 0); } while (0)
#define PG8_LDA(dst, b, h) do { _Pragma("unroll") for (int m = 0; m < 4; ++m) _Pragma("unroll") for (int k = 0; k < 2; ++k) dst[m][k] = *(const LAS bf16x8*)(lds + PG8_SA(b, h) + aoff + m * 2048 + k * 1024); } while (0)
#define PG8_LDB(dst, b, h) do { _Pragma("unroll") for (int n = 0; n < 2; ++n) _Pragma("unroll") for (int k = 0; k < 2; ++k) dst[n][k] = *(const LAS bf16x8*)(lds + PG8_SB(b, h) + boff + n * 2048 + k * 1024); } while (0)
#define PG8_MMA(ai, bj, At, Bt) do { __builtin_amdgcn_s_setprio(1); _Pragma("unroll") for (int m = 0; m < 4; ++m) _Pragma("unroll") for (int n = 0; n < 2; ++n) _Pragma("unroll") for (int k = 0; k < 2; ++k) \
        acc[ai][bj][m][n] = __builtin_amdgcn_mfma_f32_16x16x32_bf16(Bt[n][k], At[m][k], acc[ai][bj][m][n], 0, 0, 0); __builtin_amdgcn_s_setprio(0); } while (0)
#define PG8_WAIT_V(n) asm volatile("s_waitcnt vmcnt(" #n ")" ::: "memory")
#define PG8_WAIT_L(n) asm volatile("s_waitcnt lgkmcnt(" #n ")" ::: "memory")
#define PG8_BAR __builtin_amdgcn_s_barrier()
#define PG8_SCHED __builtin_amdgcn_sched_barrier(0)
    Unit cur, nxt; int ui = 0;
    if (!S.next(0, cur)) return;
    f32x4 acc[2][2][4][2];
#pragma unroll
    for (int a = 0; a < 2; ++a)
#pragma unroll
        for (int b = 0; b < 2; ++b)
#pragma unroll
            for (int m = 0; m < 4; ++m)
#pragma unroll
                for (int n = 0; n < 2; ++n) acc[a][b][m][n] = (f32x4){0.f, 0.f, 0.f, 0.f};
    bf16x8 At[4][2], B0[2][2], B1[2][2];
    const char* cA = (const char*)g.A + (size_t)cur.pm * tstep; const char* cB = (const char*)g.Bt + (size_t)cur.pn * tstep;
    S.a_ready(cur);
    if constexpr (SP2) {
        PG8_STAGE(PG8_SB(0, 0), cB, voffB); PG8_STAGE(PG8_SB(0, 1), cB + hstep, voffB); PG8_STAGE(PG8_SA(0, 0), cA, voffA); PG8_STAGE(PG8_SA(0, 1), cA + hstep, voffA);
        if (wr == 1) PG8_BAR;
        PG8_WAIT_V(2); PG8_BAR;
        PG8_STAGE(PG8_SB(1, 0), cB + kstep, voffB); PG8_STAGE(PG8_SA(1, 0), cA + kstep, voffA); PG8_STAGE(PG8_SB(1, 1), cB + hstep + kstep, voffB);
        PG8_WAIT_V(6); PG8_BAR;
    } else {
        PG8_STAGE(PG8_SB(0, 0), cB, voffB); PG8_STAGE(PG8_SA(0, 0), cA, voffA); PG8_STAGE(PG8_SB(0, 1), cB + hstep, voffB); PG8_STAGE(PG8_SA(0, 1), cA + hstep, voffA);
        if (wr == 1) PG8_BAR;
        PG8_WAIT_V(4); PG8_BAR;
        PG8_STAGE(PG8_SB(1, 0), cB + kstep, voffB); PG8_STAGE(PG8_SA(1, 0), cA + kstep, voffA); PG8_STAGE(PG8_SB(1, 1), cB + hstep + kstep, voffB);
        PG8_WAIT_V(6); PG8_BAR;
    }
    for (;;) {
        const bool has_next = S.next(ui + 1, nxt);
        const char* nA = has_next ? (const char*)g.A + (size_t)nxt.pm * tstep : cA; const char* nB = has_next ? (const char*)g.Bt + (size_t)nxt.pn * tstep : cB;
        for (int t = 0; t < nt; t += 2) {
            const bool last = (t == nt - 2);
            const char* a1 = cA + (size_t)(t + 1) * kstep;
            const char* a2 = last ? nA : cA + (size_t)(t + 2) * kstep; const char* b2 = last ? nB : cB + (size_t)(t + 2) * kstep;
            const char* a3 = a2 + kstep; const char* b3 = b2 + kstep;
            if (last && has_next) S.a_ready(nxt);
            if constexpr (SP2) {
            PG8_LDB(B0, 0, 0); PG8_LDB(B1, 0, 1); PG8_SCHED; PG8_LDA(At, 0, 0); PG8_STAGE(PG8_SA(1, 1), a1 + hstep, voffA);
            PG8_WAIT_V(8); PG8_WAIT_L(0); PG8_BAR; PG8_MMA(0, 0, At, B0); PG8_MMA(0, 1, At, B1); PG8_BAR; PG8_SCHED;
            PG8_LDA(At, 0, 1); PG8_STAGE(PG8_SB(0, 0), b2, voffB); PG8_STAGE(PG8_SB(0, 1), b2 + hstep, voffB); PG8_STAGE(PG8_SA(0, 0), a2, voffA);
            PG8_WAIT_V(8); PG8_WAIT_L(0); PG8_BAR; PG8_MMA(1, 0, At, B0); PG8_MMA(1, 1, At, B1); PG8_BAR; PG8_SCHED;
            PG8_LDB(B0, 1, 0); PG8_LDB(B1, 1, 1); PG8_SCHED; PG8_LDA(At, 1, 0); PG8_STAGE(PG8_SA(0, 1), a2 + hstep, voffA);
            PG8_WAIT_V(8); PG8_WAIT_L(0); PG8_BAR; PG8_MMA(0, 0, At, B0); PG8_MMA(0, 1, At, B1); PG8_BAR; PG8_SCHED;
            PG8_LDA(At, 1, 1); PG8_STAGE(PG8_SB(1, 0), b3, voffB); PG8_STAGE(PG8_SB(1, 1), b3 + hstep, voffB); PG8_STAGE(PG8_SA(1, 0), a3, voffA);
            PG8_WAIT_V(8); PG8_WAIT_L(0); PG8_BAR; PG8_MMA(1, 0, At, B0); PG8_MMA(1, 1, At, B1); PG8_BAR; PG8_SCHED;
            } else {
            PG8_LDB(B0, 0, 0); PG8_SCHED; PG8_LDA(At, 0, 0); PG8_STAGE(PG8_SA(1, 1), a1 + hstep, voffA);
            PG8_WAIT_L(8); PG8_BAR; PG8_WAIT_L(0); PG8_MMA(0, 0, At, B0); PG8_BAR; PG8_SCHED;
            PG8_LDB(B1, 0, 1); PG8_STAGE(PG8_SB(0, 0), b2, voffB);
            PG8_BAR; PG8_WAIT_L(0); PG8_MMA(0, 1, At, B1); PG8_BAR;
            PG8_LDA(At, 0, 1); PG8_STAGE(PG8_SA(0, 0), a2, voffA);
            PG8_BAR; PG8_WAIT_L(0); PG8_MMA(1, 0, At, B0); PG8_BAR; PG8_SCHED;
            PG8_STAGE(PG8_SB(0, 1), b2 + hstep, voffB);
            PG8_WAIT_V(6); PG8_BAR; PG8_MMA(1, 1, At, B1); PG8_BAR;
            PG8_LDB(B0, 1, 0); PG8_SCHED; PG8_LDA(At, 1, 0); PG8_STAGE(PG8_SA(0, 1), a2 + hstep, voffA);
            PG8_WAIT_L(8); PG8_BAR; PG8_WAIT_L(0); PG8_MMA(0, 0, At, B0); PG8_BAR; PG8_SCHED;
            PG8_LDB(B1, 1, 1); PG8_STAGE(PG8_SB(1, 0), b3, voffB);
            PG8_BAR; PG8_WAIT_L(0); PG8_MMA(0, 1, At, B1); PG8_BAR;
            PG8_LDA(At, 1, 1); PG8_STAGE(PG8_SA(1, 0), a3, voffA);
            PG8_BAR; PG8_WAIT_L(0); PG8_MMA(1, 0, At, B0); PG8_BAR; PG8_SCHED;
            PG8_STAGE(PG8_SB(1, 1), b3 + hstep, voffB);
            PG8_WAIT_V(6); PG8_BAR; PG8_MMA(1, 1, At, B1); PG8_BAR;
            }
        }
        if constexpr (ALIGN_EPI) { if (wr == 0) PG8_BAR; }
        if constexpr (!Epi::AFTER_DRAIN) { E(acc, cur, wr, wc, fr, fq); S.done(cur); }
        if (!has_next) break;
#pragma unroll
        for (int a = 0; a < 2; ++a)
#pragma unroll
            for (int b = 0; b < 2; ++b)
#pragma unroll
                for (int m = 0; m < 4; ++m)
#pragma unroll
                    for (int n = 0; n < 2; ++n) acc[a][b][m][n] = (f32x4){0.f, 0.f, 0.f, 0.f};
        cur = nxt; cA = nA; cB = nB; ++ui;
        if constexpr (ALIGN_EPI) { if (wr == 1) PG8_BAR; }
    }
    PG8_WAIT_V(0);
    if constexpr (!ALIGN_EPI) { if (wr == 0) PG8_BAR; }
    PG8_BAR;
#undef PG8_SA
#undef PG8_SB
#undef PG8_STAGE
#undef PG8_LDA
#undef PG8_LDB
#undef PG8_MMA
#undef PG8_WAIT_V
#undef PG8_WAIT_L
#undef PG8_BAR
#undef PG8_SCHED
}
}

typedef GAS unsigned gu32;
#define XB_TMO      128
#define XB_XCNT(j)  (256  + 64 * (j))
#define XB_XSUB(j)  (1280 + 64 * (j))
#define XB_XGEN(j)  (2304 + 64 * (j))
#define XB_TOP      3328
#define XB_TOPGEN   3392
#define XCD_BAR_WORDS 3456
#define XB_SPIN_CAP (1u << 22)
__device__ __forceinline__ unsigned xb_ld(unsigned* p)              { return __hip_atomic_load(p, __ATOMIC_RELAXED, __HIP_MEMORY_SCOPE_AGENT); }
__device__ __forceinline__ unsigned xb_add(unsigned* p, unsigned v) { return __hip_atomic_fetch_add(p, v, __ATOMIC_RELAXED, __HIP_MEMORY_SCOPE_AGENT); }
__device__ __forceinline__ unsigned xb_xcc_id() { return (unsigned)__builtin_amdgcn_s_getreg((3 << 11) | 20) & 0xFu; }
#define XB_SPIN(cond, bar) do { unsigned _sp = 0; while (cond) { __builtin_amdgcn_s_sleep(1); \
    if ((++_sp & 255u) == 0u) { if (xb_ld(&(bar)[XB_TMO])) break; if (_sp > XB_SPIN_CAP) { atomicAdd(&(bar)[XB_TMO], 1u); break; } } } } while (0)
struct XcdBarrier { unsigned* bar; unsigned x; volatile LAS unsigned* st; };
__device__ __forceinline__ XcdBarrier xcd_barrier_post(unsigned* bar, volatile LAS unsigned* st) {
    XcdBarrier b; b.bar = bar; b.x = xb_xcc_id(); b.st = st;
    if (threadIdx.x == 0) (void)xb_add(&bar[XB_XCNT(b.x)], 1u);
    return b;
}
__device__ __forceinline__ void xcd_barrier_complete(unsigned* bar, unsigned x, unsigned& nloc, unsigned& nx) {
    const unsigned G = gridDim.x * gridDim.y * gridDim.z;
    unsigned sum, cnt, mine, sp = 0u;
    for (;;) {
        sum = 0u; cnt = 0u; mine = 0u;
#pragma unroll
        for (unsigned j = 0; j < 16; ++j) { const unsigned c = xb_ld(&bar[XB_XCNT(j)]); sum += c; cnt += (c > 0u) ? 1u : 0u; mine = (j == x) ? c : mine; }
        if (sum == G) break;
        __builtin_amdgcn_s_sleep(1);
        if ((++sp & 255u) == 0u) { if (xb_ld(&bar[XB_TMO])) break; if (sp > XB_SPIN_CAP) { atomicAdd(&bar[XB_TMO], 1u); break; } }
    }
    nloc = mine > 0u ? mine : 1u; nx = cnt > 0u ? cnt : 1u;
}
__device__ __forceinline__ void xcd_barrier(const XcdBarrier& b) {
    asm volatile("s_waitcnt vmcnt(0)" ::: "memory");
    __syncthreads();
    if (threadIdx.x == 0) {
        unsigned* bar = b.bar;
        __builtin_amdgcn_s_waitcnt(0);
        unsigned nloc = b.st[0], nx = b.st[1];
        if (nloc == 0u) { xcd_barrier_complete(bar, b.x, nloc, nx); b.st[0] = nloc; b.st[1] = nx; }
        const unsigned old = xb_add(&bar[XB_XSUB(b.x)], 1u);
        const unsigned gen = old / nloc;
        if (old + 1u == (gen + 1u) * nloc) {
            __builtin_amdgcn_fence(__ATOMIC_RELEASE, "agent");
            asm volatile("s_waitcnt vmcnt(0)" ::: "memory");
            const unsigned og = xb_add(&bar[XB_TOP], 1u);
            const unsigned tg = og / nx;
            if (og + 1u == (tg + 1u) * nx) xb_add(&bar[XB_TOPGEN], 1u);
            else XB_SPIN(xb_ld(&bar[XB_TOPGEN]) == tg, bar);
            __builtin_amdgcn_fence(__ATOMIC_ACQUIRE, "agent");
            xb_add(&bar[XB_XGEN(b.x)], 1u);
            asm volatile("s_waitcnt vmcnt(0)" ::: "memory");
        } else {
            XB_SPIN(xb_ld(&bar[XB_XGEN(b.x)]) == gen, bar);
            __builtin_amdgcn_fence(__ATOMIC_ACQUIRE, "agent");
            asm volatile("s_waitcnt vmcnt(0)" ::: "memory");
        }
    }
    __syncthreads();
}

struct Args { const float* in[23]; float* out; unsigned char* ws; int ph_lo, ph_hi; };
enum { I_X = 0, I_C, I_POS, I_WADA, I_BADA, I_WIN, I_CONVW, I_CONVB, I_DTB, I_ALOG, I_DSKIP, I_NORMW, I_SINK, I_WOUT, I_LN1G, I_LN1B, I_WQ, I_K1, I_K2, I_U, I_V, I_LN2G, I_LN2B };

__device__ __forceinline__ void p0_transpose_item(const float* W, int K, int N, int Npad, bf16_t* WT, LAS float* scr, int item, int lane) {
    const int nblk = Npad / 32, kb = item / nblk, nb = item % nblk, k0 = 64 * kb, n0 = 32 * nb;
    const int ncol = n0 + (lane & 31);
#pragma unroll 8
    for (int i = 0; i < 32; ++i) { const int kk = 2 * i + (lane >> 5); scr[kk * 33 + (lane & 31)] = (ncol < N) ? W[(size_t)(k0 + kk) * N + ncol] : 0.f; }
    asm volatile("s_waitcnt lgkmcnt(0)" ::: "memory");
    const int c = lane & 7;
#pragma unroll
    for (int j = 0; j < 4; ++j) { const int n = (lane >> 3) + 8 * j; const LAS float* s = scr + (8 * c) * 33 + n;
        u32x4 o; o.x = cvt_pk_bf16(s[0 * 33], s[1 * 33]); o.y = cvt_pk_bf16(s[2 * 33], s[3 * 33]); o.z = cvt_pk_bf16(s[4 * 33], s[5 * 33]); o.w = cvt_pk_bf16(s[6 * 33], s[7 * 33]);
        *(u32x4*)(WT + (size_t)(n0 + n) * K + k0 + 8 * c) = o; }
    asm volatile("s_waitcnt lgkmcnt(0)" ::: "memory");
}

__device__ __forceinline__ void phase0(const Args& a, LAS unsigned char* lds, int bid, int nb, int tid) {
    unsigned char* ws = a.ws;
    const int wave = tid >> 6, lane = tid & 63;
    {
        const float* c = a.in[I_C]; const float* w_ada = a.in[I_WADA]; float* modp = (float*)(ws + WS_MODP);
        for (int item = bid; item < 256; item += nb) {
            const int kc = item >> 3, ns = item & 7, k0 = kc * 64, n0 = ns * 1536;
            if (tid < 384) {
                f32x4 acc = {0.f, 0.f, 0.f, 0.f};
                const float* wp = w_ada + (size_t)k0 * 12288 + n0 + tid * 4;
#pragma unroll 8
                for (int k = 0; k < 64; ++k) { const float cv = c[k0 + k]; const float s = cv / (1.f + __expf(-cv)); const f32x4 w = *(const f32x4*)(wp + (size_t)k * 12288); acc += w * s; }
                *(f32x4*)(modp + (size_t)kc * 12288 + n0 + tid * 4) = acc;
            }
        }
    }
    {
        LAS float* scr = (LAS float*)(lds + wave * 16384);
        const int gw = bid * 8 + wave, NGW = nb * 8;
        constexpr int I_IN = (D / 64) * (NINP / 32), I_OUT = (D / 64) * (D / 32);
        for (int it = gw; it < I_IN + I_OUT; it += NGW) {
            if (it < I_IN) p0_transpose_item(a.in[I_WIN], D, NIN, NINP, (bf16_t*)(ws + WS_WIN), scr, it, lane);
            else p0_transpose_item(a.in[I_WOUT], D, D, D, (bf16_t*)(ws + WS_WOUT), scr, it - I_IN, lane);
        }
    }
    __syncthreads();
    {
        LAS float* keyS = (LAS float*)lds;
        LAS float* wqS = keyS + 128 * 65;
        bf16_t* WSC = (bf16_t*)(ws + WS_WSC);
        for (int item = bid; item < 512; item += nb) {
            const int half = item & 1, h = (item >> 1) & 7, db = item >> 4, d0 = db * 64;
            const float* keys = a.in[half ? I_K2 : I_K1];
            const float* wq = a.in[I_WQ];
#pragma unroll
            for (int i = 0; i < 16; ++i) { const int e = tid + i * 512; keyS[(e >> 6) * 65 + (e & 63)] = keys[e]; }
#pragma unroll
            for (int i = 0; i < 8; ++i) { const int e = tid + i * 512; const int dd = e >> 6, k = e & 63; wqS[dd * 65 + k] = wq[(size_t)(d0 + dd) * 1024 + h * 128 + half * 64 + k]; }
            __syncthreads();
            const int dd = tid & 63, ng = tid >> 6;
            float acc[16];
#pragma unroll
            for (int i = 0; i < 16; ++i) acc[i] = 0.f;
            for (int k = 0; k < 64; ++k) { const float wv = wqS[dd * 65 + k];
#pragma unroll
                for (int i = 0; i < 16; ++i) acc[i] += wv * keyS[(ng * 16 + i) * 65 + k]; }
#pragma unroll
            for (int i = 0; i < 16; ++i) WSC[(size_t)(half * 1024 + h * 128 + ng * 16 + i) * D + d0 + dd] = f2bf(acc[i]);
            __syncthreads();
        }
    }
    {
        const size_t nthr = (size_t)nb * 512, gt = (size_t)bid * 512 + tid;
        const float* U = a.in[I_U]; unsigned char* UQ = ws + WS_UQ;
        for (size_t i = gt; i < (size_t)16384 * 128; i += nthr) {
            const int e = (int)(i >> 7), j16 = (int)(i & 127), sl = j16 >> 3, c = j16 & 7, g = e >> 10, el = e & 1023;
            const float* src = U + (size_t)e * D + j16 * 16;
            const f32x4 v0 = *(const f32x4*)src * 64.f, v1 = *(const f32x4*)(src + 4) * 64.f, v2 = *(const f32x4*)(src + 8) * 64.f, v3 = *(const f32x4*)(src + 12) * 64.f;
            u32x4 o = {0u, 0u, 0u, 0u};
            o.x = __builtin_amdgcn_cvt_pk_fp8_f32(v0[0], v0[1], o.x, false); o.x = __builtin_amdgcn_cvt_pk_fp8_f32(v0[2], v0[3], o.x, true);
            o.y = __builtin_amdgcn_cvt_pk_fp8_f32(v1[0], v1[1], o.y, false); o.y = __builtin_amdgcn_cvt_pk_fp8_f32(v1[2], v1[3], o.y, true);
            o.z = __builtin_amdgcn_cvt_pk_fp8_f32(v2[0], v2[1], o.z, false); o.z = __builtin_amdgcn_cvt_pk_fp8_f32(v2[2], v2[3], o.z, true);
            o.w = __builtin_amdgcn_cvt_pk_fp8_f32(v3[0], v3[1], o.w, false); o.w = __builtin_amdgcn_cvt_pk_fp8_f32(v3[2], v3[3], o.w, true);
            *(u32x4*)(UQ + ((size_t)((g * 16 + sl) * 1024 + el)) * 128 + ((c ^ (el & 7)) * 16)) = o;
        }
    }
    __syncthreads();
    {
        const float* V = a.in[I_V]; unsigned char* VQ = ws + WS_VQ;
        for (int tile = bid; tile < 1024; tile += nb) {
            const int e0 = tile * 16;
#pragma unroll
            for (int i = 0; i < 8; ++i) { const int unit = tid + i * 512, e = unit >> 8, j8 = unit & 255;
                const f32x4 v0 = *(const f32x4*)(V + (size_t)(e0 + e) * D + j8 * 8), v1 = *(const f32x4*)(V + (size_t)(e0 + e) * D + j8 * 8 + 4);
                unsigned w0 = 0u, w1 = 0u;
                w0 = __builtin_amdgcn_cvt_pk_fp8_f32(v0[0], v0[1], w0, false); w0 = __builtin_amdgcn_cvt_pk_fp8_f32(v0[2], v0[3], w0, true);
                w1 = __builtin_amdgcn_cvt_pk_fp8_f32(v1[0], v1[1], w1, false); w1 = __builtin_amdgcn_cvt_pk_fp8_f32(v1[2], v1[3], w1, true);
                *(LAS u32x2*)(lds + e * 2056 + j8 * 8) = (u32x2){w0, w1}; }
            __syncthreads();
#pragma unroll
            for (int i = 0; i < 8; ++i) { const int unit = tid + i * 512, c = unit >> 4, e = unit & 15;
                *(u32x2*)(VQ + ((size_t)c * 16384 + e0 + e) * 8) = *(const LAS u32x2*)(lds + e * 2056 + c * 8); }
            __syncthreads();
        }
    }
    {
        const int* pos = (const int*)a.in[I_POS]; f32x2* rope = (f32x2*)(ws + WS_ROPE);
        for (int e = bid * 512 + tid; e < S * 8; e += nb * 512) {
            const int t = e >> 3, i = e & 7;
            const float invs[8] = {1.0f, 0.19392274474868576f, 0.03760603093086393f, 0.007292664737217109f, 0.001414213562373095f, 0.0002742481756762073f, 5.318295896944988e-05f, 1.031338537721246e-05f};
            float inv = invs[0];
#pragma unroll
            for (int j = 1; j < 8; ++j) inv = (i == j) ? invs[j] : inv;
            const float ang = (float)pos[t] * inv;
            float sn, cs; sincosf(ang, &sn, &cs);
            rope[e] = (f32x2){cs, sn};
        }
    }
}

__device__ __forceinline__ void phase1(const Args& a, int bid, int nb, int tid) {
    const float* modp = (const float*)(a.ws + WS_MODP); float* mod = (float*)(a.ws + WS_MOD); const float* b_ada = a.in[I_BADA];
    for (int n = bid * 512 + tid; n < 12288; n += nb * 512) { float s = b_ada[n];
#pragma unroll 8
        for (int k = 0; k < 32; ++k) s += modp[(size_t)k * 12288 + n];
        mod[n] = s; }
}

__device__ __forceinline__ void phase2(const Args& a, int bid, int nb, int tid) {
    const float* x = a.in[I_X]; const float* mod = (const float*)(a.ws + WS_MOD); bf16_t* H = (bf16_t*)(a.ws + WS_H);
    const size_t n8 = (size_t)S * D / 8, nthr = (size_t)nb * 512;
    for (size_t i = (size_t)bid * 512 + tid; i < n8; i += nthr) {
        const int col = (int)((i * 8) & (D - 1));
        const f32x4 v0 = *(const f32x4*)(x + i * 8), v1 = *(const f32x4*)(x + i * 8 + 4);
        const f32x4 sh0 = *(const f32x4*)(mod + col), sh1 = *(const f32x4*)(mod + col + 4), sc0 = *(const f32x4*)(mod + D + col), sc1 = *(const f32x4*)(mod + D + col + 4);
        const f32x4 h0 = v0 * (sc0 + 1.0f) + sh0, h1 = v1 * (sc1 + 1.0f) + sh1;
        u32x4 o; o.x = cvt_pk_bf16(h0[0], h0[1]); o.y = cvt_pk_bf16(h0[2], h0[3]); o.z = cvt_pk_bf16(h1[0], h1[1]); o.w = cvt_pk_bf16(h1[2], h1[3]);
        *(u32x4*)(H + i * 8) = o;
    }
}

__device__ __forceinline__ void rope16(u32x4& a, u32x4& b, const f32x2* rp) {
    float t1[8], t2[8];
    t1[0] = bf_lo(a.x); t1[1] = bf_hi(a.x); t1[2] = bf_lo(a.y); t1[3] = bf_hi(a.y); t1[4] = bf_lo(a.z); t1[5] = bf_hi(a.z); t1[6] = bf_lo(a.w); t1[7] = bf_hi(a.w);
    t2[0] = bf_lo(b.x); t2[1] = bf_hi(b.x); t2[2] = bf_lo(b.y); t2[3] = bf_hi(b.y); t2[4] = bf_lo(b.z); t2[5] = bf_hi(b.z); t2[6] = bf_lo(b.w); t2[7] = bf_hi(b.w);
    float o1[8], o2[8];
#pragma unroll
    for (int i = 0; i < 8; ++i) { const f32x2 cs = rp[i]; o1[i] = t1[i] * cs.x - t2[i] * cs.y; o2[i] = t2[i] * cs.x + t1[i] * cs.y; }
    a.x = cvt_pk_bf16(o1[0], o1[1]); a.y = cvt_pk_bf16(o1[2], o1[3]); a.z = cvt_pk_bf16(o1[4], o1[5]); a.w = cvt_pk_bf16(o1[6], o1[7]);
    b.x = cvt_pk_bf16(o2[0], o2[1]); b.y = cvt_pk_bf16(o2[2], o2[3]); b.z = cvt_pk_bf16(o2[4], o2[5]); b.w = cvt_pk_bf16(o2[6], o2[7]);
}

__device__ __forceinline__ void attn_item(const Args& a, LAS unsigned char* lds, int qb, int hd, int tid) {
    const bf16_t* PROJ = (const bf16_t*)(a.ws + WS_PROJ); const f32x2* ROPE = (const f32x2*)(a.ws + WS_ROPE); bf16_t* MIXIN = (bf16_t*)(a.ws + WS_MIXIN);
    LAS bf16_t* Ks = (LAS bf16_t*)lds;
    LAS bf16_t* Qs = Ks + 256 * 72;
    LAS bf16_t* Vt = Qs + 128 * 72;
    const int kvh = hd >> 3, t0 = qb * 128;
    {
        const int row = tid >> 2, q4 = tid & 3, tok = t0 + row;
        const bf16_t* src = PROJ + (size_t)tok * NINP + hd * 64 + q4 * 16;
        u32x4 x0 = *(const u32x4*)src, x1 = *(const u32x4*)(src + 8);
        if (q4 == 0) rope16(x0, x1, ROPE + tok * 8);
        *(LAS u32x4*)(Qs + row * 72 + q4 * 16) = x0; *(LAS u32x4*)(Qs + row * 72 + q4 * 16 + 8) = x1;
    }
#pragma unroll
    for (int i = 0; i < 2; ++i) {
        const int idx = tid + i * 512, row = idx >> 2, q4 = idx & 3, tok = t0 - 128 + row;
        u32x4 x0 = {0u, 0u, 0u, 0u}, x1 = {0u, 0u, 0u, 0u};
        if (tok >= 0) { const bf16_t* src = PROJ + (size_t)tok * NINP + 1024 + kvh * 64 + q4 * 16; x0 = *(const u32x4*)src; x1 = *(const u32x4*)(src + 8); if (q4 == 0) rope16(x0, x1, ROPE + tok * 8); }
        *(LAS u32x4*)(Ks + row * 72 + q4 * 16) = x0; *(LAS u32x4*)(Ks + row * 72 + q4 * 16 + 8) = x1;
    }
#pragma unroll
    for (int i = 0; i < 4; ++i) {
        const int idx = tid + i * 512, key = idx >> 3, ch = idx & 7, tok = t0 - 128 + key;
        u32x4 v = {0u, 0u, 0u, 0u};
        if (tok >= 0) v = *(const u32x4*)(PROJ + (size_t)tok * NINP + 1152 + kvh * 64 + ch * 8);
        LAS bf16_t* dst = Vt + (ch * 8) * 264 + key;
        dst[0 * 264] = (bf16_t)(v.x & 0xffffu); dst[1 * 264] = (bf16_t)(v.x >> 16); dst[2 * 264] = (bf16_t)(v.y & 0xffffu); dst[3 * 264] = (bf16_t)(v.y >> 16);
        dst[4 * 264] = (bf16_t)(v.z & 0xffffu); dst[5 * 264] = (bf16_t)(v.z >> 16); dst[6 * 264] = (bf16_t)(v.w & 0xffffu); dst[7 * 264] = (bf16_t)(v.w >> 16);
    }
    __syncthreads();
    const int w = tid >> 6, lane = tid & 63, fr = lane & 15, kq = lane >> 4;
    bf16x8 qf[2];
#pragma unroll
    for (int ks = 0; ks < 2; ++ks) qf[ks] = *(const LAS bf16x8*)(Qs + (16 * w + fr) * 72 + 32 * ks + 8 * kq);
    f32x4 s[16];
#pragma unroll
    for (int t = 0; t < 16; ++t) { s[t] = (f32x4){0.f, 0.f, 0.f, 0.f};
        if (t >= w && t <= w + 8) {
#pragma unroll
        for (int ks = 0; ks < 2; ++ks) { const bf16x8 kf = *(const LAS bf16x8*)(Ks + (16 * t + fr) * 72 + 32 * ks + 8 * kq); s[t] = __builtin_amdgcn_mfma_f32_16x16x32_bf16(kf, qf[ks], s[t], 0, 0, 0); } } }
    const float sink = a.in[I_SINK][hd];
    const int qi = 16 * w + fr;
    float mx = sink;
#pragma unroll
    for (int t = 0; t < 16; ++t)
#pragma unroll
        for (int r = 0; r < 4; ++r) { const int j = 16 * t + 4 * kq + r; const bool valid = (j > qi) && (j <= qi + 128) && (qb > 0 || j >= 128);
            const float v = valid ? s[t][r] * 0.125f : -INFINITY; s[t][r] = v; mx = fmaxf(mx, v); }
    mx = fmaxf(mx, __shfl_xor(mx, 16)); mx = fmaxf(mx, __shfl_xor(mx, 32));
    float sum = 0.f;
#pragma unroll
    for (int t = 0; t < 16; ++t) {
        if (t >= w && t <= w + 8) {
#pragma unroll
        for (int r = 0; r < 4; ++r) { const float p = __expf(s[t][r] - mx); s[t][r] = p; sum += p; }
        } else s[t] = (f32x4){0.f, 0.f, 0.f, 0.f}; }
    sum += __shfl_xor(sum, 16); sum += __shfl_xor(sum, 32);
    const float inv = 1.f / (sum + __expf(sink - mx));
    f32x4 o[4];
#pragma unroll
    for (int dt = 0; dt < 4; ++dt) o[dt] = (f32x4){0.f, 0.f, 0.f, 0.f};
#pragma unroll
    for (int u = 0; u < 8; ++u) {
        if (2 * u + 1 < w || 2 * u > w + 8) continue;
        u32x4 pw; pw.x = cvt_pk_bf16(s[2 * u][0] * inv, s[2 * u][1] * inv); pw.y = cvt_pk_bf16(s[2 * u][2] * inv, s[2 * u][3] * inv);
        pw.z = cvt_pk_bf16(s[2 * u + 1][0] * inv, s[2 * u + 1][1] * inv); pw.w = cvt_pk_bf16(s[2 * u + 1][2] * inv, s[2 * u + 1][3] * inv);
        const bf16x8 pf = __builtin_bit_cast(bf16x8, pw);
#pragma unroll
        for (int dt = 0; dt < 4; ++dt) { const LAS bf16_t* vp = Vt + (16 * dt + fr) * 264 + 32 * u + 4 * kq;
            const u32x2 lo = *(const LAS u32x2*)vp, hi = *(const LAS u32x2*)(vp + 16);
            const u32x4 vw = {lo.x, lo.y, hi.x, hi.y};
            o[dt] = __builtin_amdgcn_mfma_f32_16x16x32_bf16(pf, __builtin_bit_cast(bf16x8, vw), o[dt], 0, 0, 0); }
    }
#pragma unroll
    for (int dt = 0; dt < 4; ++dt)
#pragma unroll
        for (int r = 0; r < 4; ++r) MIXIN[(size_t)(t0 + 16 * w + 4 * kq + r) * D + hd * 64 + 16 * dt + fr] = f2bf(o[dt][r]);
    __syncthreads();
}

__device__ __forceinline__ void conv_unit(const bf16_t* PROJ, const float* convw, const float* convb, int xch, int tok0, int l0, float (&o0)[8], float (&o1)[8]) {
    float w0[4], w1[4];
#pragma unroll
    for (int q = 0; q < 4; ++q) { w0[q] = convw[q * 1536 + xch]; w1[q] = convw[q * 1536 + xch + 1]; }
    const float b0 = convb[xch], b1 = convb[xch + 1];
    float r0[11], r1[11];
#pragma unroll
    for (int r = 0; r < 11; ++r) { const int tok = tok0 + l0 - 3 + r; unsigned u = 0u; if (tok >= 0) u = *(const unsigned*)(PROJ + (size_t)tok * NINP + 2304 + xch); r0[r] = bf_lo(u); r1[r] = bf_hi(u); }
#pragma unroll
    for (int j = 0; j < 8; ++j) { float v0 = b0, v1 = b1;
#pragma unroll
        for (int q = 0; q < 4; ++q) { v0 += w0[q] * r0[j + q]; v1 += w1[q] * r1[j + q]; }
        o0[j] = silu_f(v0); o1[j] = silu_f(v1); }
}
__device__ __forceinline__ u32x4 pack8(const float (&x)[8]) { u32x4 p; p.x = cvt_pk_bf16(x[0], x[1]); p.y = cvt_pk_bf16(x[2], x[3]); p.z = cvt_pk_bf16(x[4], x[5]); p.w = cvt_pk_bf16(x[6], x[7]); return p; }

__device__ __forceinline__ void ssda_item(const Args& a, LAS unsigned char* lds, int c, int g, int hq, int tid) {
    unsigned char* ws = a.ws;
    const bf16_t* PROJ = (const bf16_t*)(ws + WS_PROJ); const float* DT = (const float*)(ws + WS_DT); float* ACUM = (float*)(ws + WS_ACUM);
    bf16_t* XS = (bf16_t*)(ws + WS_XS); bf16_t* CPOST = (bf16_t*)(ws + WS_CPOST); float* YDIAG = (float*)(ws + WS_YDIAG); float* STATE = (float*)(ws + WS_STATE);
    LAS bf16_t* Bs = (LAS bf16_t*)lds;
    LAS bf16_t* BT = Bs + 128 * 136;
    LAS bf16_t* Cs = BT + 128 * 136;
    LAS bf16_t* XT = Cs + 128 * 136;
    LAS bf16_t* XDT = XT + 64 * 136;
    LAS float* dtS = (LAS float*)(XDT + 64 * 136);
    LAS float* acS = dtS + 512;
    const int tok0 = c * 128, h0 = g * 8 + hq * 4;
    const int w = tid >> 6, lane = tid & 63, fr = lane & 15, kq = lane >> 4;
    const float* convw = a.in[I_CONVW]; const float* convb = a.in[I_CONVB];
    if (w < 4) {
        const int h = h0 + w;
        const float d0 = DT[(size_t)(tok0 + 2 * lane) * 16 + h], d1 = DT[(size_t)(tok0 + 2 * lane + 1) * 16 + h];
        const float A = -__expf(a.in[I_ALOG][h]);
        const float a0 = d0 * A, a1 = d1 * A;
        float sc = a0 + a1;
#pragma unroll
        for (int off = 1; off < 64; off <<= 1) { const float v = __shfl_up(sc, off); if (lane >= off) sc += v; }
        dtS[w * 128 + 2 * lane] = d0; dtS[w * 128 + 2 * lane + 1] = d1; acS[w * 128 + 2 * lane] = sc - a1; acS[w * 128 + 2 * lane + 1] = sc;
        ACUM[(size_t)(tok0 + 2 * lane) * 16 + h] = sc - a1; ACUM[(size_t)(tok0 + 2 * lane + 1) * 16 + h] = sc;
    }
#pragma unroll 1
    for (int i = 0; i < 4; ++i) {
        const int idx = tid + i * 512, cp = idx & 127, tg = idx >> 7, ci = cp * 2, l0 = tg * 8;
        float o0[8], o1[8];
        conv_unit(PROJ, convw, convb, 1024 + ((ci < 128) ? g * 128 + ci : 256 + g * 128 + (ci - 128)), tok0, l0, o0, o1);
        if (ci < 128) {
#pragma unroll
            for (int j = 0; j < 8; ++j) *(LAS unsigned*)(Bs + (l0 + j) * 136 + ci) = cvt_pk_bf16(o0[j], o1[j]);
            *(LAS u32x4*)(BT + ci * 136 + l0) = pack8(o0); *(LAS u32x4*)(BT + (ci + 1) * 136 + l0) = pack8(o1);
        } else {
            const int n = ci - 128;
#pragma unroll
            for (int j = 0; j < 8; ++j) { const unsigned pk = cvt_pk_bf16(o0[j], o1[j]); *(LAS unsigned*)(Cs + (l0 + j) * 136 + n) = pk;
                if (hq == 0) *(unsigned*)(CPOST + (size_t)(tok0 + l0 + j) * 256 + g * 128 + n) = pk; }
        }
    }
    __syncthreads();
    f32x4 s[8];
    {
        bf16x8 cf[4];
#pragma unroll
        for (int ks = 0; ks < 4; ++ks) cf[ks] = *(const LAS bf16x8*)(Cs + (16 * w + fr) * 136 + 32 * ks + 8 * kq);
#pragma unroll
        for (int t = 0; t < 8; ++t) { s[t] = (f32x4){0.f, 0.f, 0.f, 0.f};
            if (t <= w) {
#pragma unroll
                for (int ks = 0; ks < 4; ++ks) { const bf16x8 bf = *(const LAS bf16x8*)(Bs + (16 * t + fr) * 136 + 32 * ks + 8 * kq); s[t] = __builtin_amdgcn_mfma_f32_16x16x32_bf16(bf, cf[ks], s[t], 0, 0, 0); } } }
    }
#pragma unroll 1
    for (int j4 = 0; j4 < 4; ++j4) {
        const int h = h0 + j4;
        const LAS float* dth = dtS + j4 * 128; const LAS float* ach = acS + j4 * 128;
        {
            const int cp = tid & 31, tg = tid >> 5, ci = cp * 2, l0 = tg * 8;
            float o0[8], o1[8];
            conv_unit(PROJ, convw, convb, h * 64 + ci, tok0, l0, o0, o1);
            const float acEnd = ach[127];
            float x0[8], x1[8], y0[8], y1[8];
#pragma unroll
            for (int j = 0; j < 8; ++j) { const float dtv = dth[l0 + j], dec = __expf(acEnd - ach[l0 + j]);
                *(unsigned*)(XS + (size_t)(tok0 + l0 + j) * 1024 + h * 64 + ci) = cvt_pk_bf16(o0[j], o1[j]);
                x0[j] = o0[j] * dtv; x1[j] = o1[j] * dtv; y0[j] = x0[j] * dec; y1[j] = x1[j] * dec; }
            *(LAS u32x4*)(XT + ci * 136 + l0) = pack8(x0); *(LAS u32x4*)(XT + (ci + 1) * 136 + l0) = pack8(x1);
            *(LAS u32x4*)(XDT + ci * 136 + l0) = pack8(y0); *(LAS u32x4*)(XDT + (ci + 1) * 136 + l0) = pack8(y1);
        }
        __syncthreads();
        const int li = 16 * w + fr; const float al = ach[li];
        f32x4 o[4];
#pragma unroll
        for (int pt = 0; pt < 4; ++pt) o[pt] = (f32x4){0.f, 0.f, 0.f, 0.f};
#pragma unroll
        for (int u = 0; u < 4; ++u) {
            if (2 * u <= w) {
                float p[8];
#pragma unroll
                for (int q = 0; q < 8; ++q) { const int t = 2 * u + (q >> 2), r = q & 3, si = 16 * t + 4 * kq + r; p[q] = (si <= li) ? s[t][r] * __expf(al - ach[si]) : 0.f; }
                const bf16x8 pf = __builtin_bit_cast(bf16x8, pack8(p));
#pragma unroll
                for (int pt = 0; pt < 4; ++pt) { const LAS bf16_t* xp = XT + (16 * pt + fr) * 136 + 32 * u + 4 * kq;
                    const u32x2 lo = *(const LAS u32x2*)xp, hi = *(const LAS u32x2*)(xp + 16); const u32x4 vw = {lo.x, lo.y, hi.x, hi.y};
                    o[pt] = __builtin_amdgcn_mfma_f32_16x16x32_bf16(pf, __builtin_bit_cast(bf16x8, vw), o[pt], 0, 0, 0); }
            }
        }
#pragma unroll
        for (int pt = 0; pt < 4; ++pt)
#pragma unroll
            for (int r = 0; r < 4; ++r) YDIAG[(size_t)(tok0 + 16 * w + 4 * kq + r) * 1024 + h * 64 + 16 * pt + fr] = o[pt][r];
#pragma unroll
        for (int pt = 0; pt < 4; ++pt) {
            f32x4 acc = {0.f, 0.f, 0.f, 0.f};
#pragma unroll
            for (int ks = 0; ks < 4; ++ks) { const bf16x8 af = *(const LAS bf16x8*)(XDT + (16 * pt + fr) * 136 + 32 * ks + 8 * kq); const bf16x8 bf = *(const LAS bf16x8*)(BT + (16 * w + fr) * 136 + 32 * ks + 8 * kq);
                acc = __builtin_amdgcn_mfma_f32_16x16x32_bf16(af, bf, acc, 0, 0, 0); }
#pragma unroll
            for (int r = 0; r < 4; ++r) STATE[((size_t)(c * 16 + h) * 64 + 16 * pt + 4 * kq + r) * 128 + 16 * w + fr] = acc[r];
        }
        __syncthreads();
    }
}

__device__ __forceinline__ void phase5(const Args& a, int bid, int nb, int tid) {
    const float* STATE = (const float*)(a.ws + WS_STATE); const float* ACUM = (const float*)(a.ws + WS_ACUM); bf16_t* HIN = (bf16_t*)(a.ws + WS_HIN);
    for (int e = bid * 512 + tid; e < 16 * 64 * 128; e += nb * 512) {
        const int h = e >> 13; float hin = 0.f;
#pragma unroll 8
        for (int c = 0; c < 64; ++c) { const size_t off = (size_t)c * 131072 + e; HIN[off] = f2bf(hin);
            const float dec = __expf(ACUM[(size_t)(c * 128 + 127) * 16 + h]); hin = dec * hin + STATE[off]; }
    }
}

__device__ __forceinline__ void ssdb_item(const Args& a, LAS unsigned char* lds, int hc, int g, int tid) {
    unsigned char* ws = a.ws;
    const bf16_t* PROJ = (const bf16_t*)(ws + WS_PROJ); const float* ACUM = (const float*)(ws + WS_ACUM); const bf16_t* XS = (const bf16_t*)(ws + WS_XS);
    const bf16_t* CPOST = (const bf16_t*)(ws + WS_CPOST); const float* YDIAG = (const float*)(ws + WS_YDIAG); const bf16_t* HIN = (const bf16_t*)(ws + WS_HIN);
    bf16_t* MIXIN = (bf16_t*)(ws + WS_MIXIN);
    LAS float* ssq = (LAS float*)lds;
    const int w = tid >> 6, lane = tid & 63, fr = lane & 15, kq = lane >> 4;
    const int h = g * 8 + w, t0 = hc * 64, c = hc >> 1;
    f32x4 acc[4][4];
#pragma unroll
    for (int lt = 0; lt < 4; ++lt)
#pragma unroll
        for (int pt = 0; pt < 4; ++pt) acc[lt][pt] = (f32x4){0.f, 0.f, 0.f, 0.f};
    const bf16_t* hb = HIN + (size_t)(c * 16 + h) * 64 * 128;
#pragma unroll
    for (int ks = 0; ks < 4; ++ks) {
        bf16x8 cfr[4], hfr[4];
#pragma unroll
        for (int lt = 0; lt < 4; ++lt) cfr[lt] = *(const bf16x8*)(CPOST + (size_t)(t0 + 16 * lt + fr) * 256 + g * 128 + 32 * ks + 8 * kq);
#pragma unroll
        for (int pt = 0; pt < 4; ++pt) hfr[pt] = *(const bf16x8*)(hb + (size_t)(16 * pt + fr) * 128 + 32 * ks + 8 * kq);
#pragma unroll
        for (int lt = 0; lt < 4; ++lt)
#pragma unroll
            for (int pt = 0; pt < 4; ++pt) acc[lt][pt] = __builtin_amdgcn_mfma_f32_16x16x32_bf16(cfr[lt], hfr[pt], acc[lt][pt], 0, 0, 0);
    }
    const float dsk = a.in[I_DSKIP][h];
    float part[4][4];
#pragma unroll
    for (int lt = 0; lt < 4; ++lt)
#pragma unroll
        for (int r = 0; r < 4; ++r) {
            const int tok = t0 + 16 * lt + 4 * kq + r; const float ea = __expf(ACUM[(size_t)tok * 16 + h]); float sq = 0.f;
#pragma unroll
            for (int pt = 0; pt < 4; ++pt) { const int ch = h * 64 + 16 * pt + fr;
                const float xs = __uint_as_float((unsigned)XS[(size_t)tok * 1024 + ch] << 16); const float z = __uint_as_float((unsigned)PROJ[(size_t)tok * NINP + 1280 + ch] << 16);
                const float y = YDIAG[(size_t)tok * 1024 + ch] + acc[lt][pt][r] * ea + dsk * xs; const float gv = y * silu_f(z); acc[lt][pt][r] = gv; sq += gv * gv; }
            sq += __shfl_xor(sq, 1); sq += __shfl_xor(sq, 2); sq += __shfl_xor(sq, 4); sq += __shfl_xor(sq, 8);
            part[lt][r] = sq;
        }
    if (fr == 0) {
#pragma unroll
        for (int lt = 0; lt < 4; ++lt)
#pragma unroll
            for (int r = 0; r < 4; ++r) ssq[(16 * lt + 4 * kq + r) * 8 + w] = part[lt][r];
    }
    __syncthreads();
    const float* nw = a.in[I_NORMW];
#pragma unroll
    for (int lt = 0; lt < 4; ++lt)
#pragma unroll
        for (int r = 0; r < 4; ++r) {
            const int l = 16 * lt + 4 * kq + r; float tot = 0.f;
#pragma unroll
            for (int ww = 0; ww < 8; ++ww) tot += ssq[l * 8 + ww];
            const float rs = rsqrtf(tot * (1.f / 512.f) + LN_EPS);
#pragma unroll
            for (int pt = 0; pt < 4; ++pt) { const int ch = h * 64 + 16 * pt + fr; MIXIN[(size_t)(t0 + l) * D + 1024 + ch] = f2bf(acc[lt][pt][r] * rs * nw[ch]); }
        }
    __syncthreads();
}

__device__ __forceinline__ void phase8(const Args& a, int bid, int nb, int tid) {
    float* P = (float*)(a.ws + WS_PRE1); bf16_t* H = (bf16_t*)(a.ws + WS_H); const float* mod = (const float*)(a.ws + WS_MOD); unsigned char* H2Q = a.ws + WS_H2Q;
    const float* gam = a.in[I_LN1G]; const float* bet = a.in[I_LN1B];
    const int wave = tid >> 6, lane = tid & 63;
    for (int row = bid * 8 + wave; row < S; row += nb * 8) {
        float* pr = P + (size_t)row * D;
        f32x4 v[8]; float s = 0.f;
#pragma unroll
        for (int j = 0; j < 8; ++j) { v[j] = *(const f32x4*)(pr + 4 * lane + 256 * j); s += (v[j][0] + v[j][1]) + (v[j][2] + v[j][3]); }
        const float mean = wave_sum(s) * (1.f / D); float q = 0.f;
#pragma unroll
        for (int j = 0; j < 8; ++j) { v[j] = v[j] - mean; q += (v[j][0] * v[j][0] + v[j][1] * v[j][1]) + (v[j][2] * v[j][2] + v[j][3] * v[j][3]); }
        const float rstd = rsqrtf(wave_sum(q) * (1.f / D) + LN_EPS);
#pragma unroll
        for (int j = 0; j < 8; ++j) { const int col = 4 * lane + 256 * j;
            const f32x4 x1 = v[j] * rstd * *(const f32x4*)(gam + col) + *(const f32x4*)(bet + col);
            *(f32x4*)(pr + col) = x1;
            const f32x4 h2 = x1 * (*(const f32x4*)(mod + 4 * D + col) + 1.0f) + *(const f32x4*)(mod + 3 * D + col);
            u32x2 o; o.x = cvt_pk_bf16(h2[0], h2[1]); o.y = cvt_pk_bf16(h2[2], h2[3]);
            *(u32x2*)(H + (size_t)row * D + col) = o;
            unsigned q8 = 0u; q8 = __builtin_amdgcn_cvt_pk_fp8_f32(h2[0], h2[1], q8, false); q8 = __builtin_amdgcn_cvt_pk_fp8_f32(h2[2], h2[3], q8, true);
            *(unsigned*)(H2Q + (size_t)row * D + col) = q8; }
    }
}

template <int CTRL, int RM> __device__ __forceinline__ float dppf(float old, float src) { return __int_as_float(__builtin_amdgcn_update_dpp(__float_as_int(old), __float_as_int(src), CTRL, RM, 0xf, false)); }
__device__ __forceinline__ float wave_max_dpp(float v) {
    const float ni = -INFINITY;
    v = fmaxf(v, dppf<0x111, 0xf>(ni, v)); v = fmaxf(v, dppf<0x112, 0xf>(ni, v)); v = fmaxf(v, dppf<0x114, 0xf>(ni, v)); v = fmaxf(v, dppf<0x118, 0xf>(ni, v));
    v = fmaxf(v, dppf<0x142, 0xa>(ni, v)); v = fmaxf(v, dppf<0x143, 0xc>(ni, v));
    return __int_as_float(__builtin_amdgcn_readlane(__float_as_int(v), 63));
}
template <int NV> __device__ __forceinline__ float topk_thresh(const float (&x)[NV]) {
    float mx = x[0], mn = x[0];
#pragma unroll
    for (int i = 1; i < NV; ++i) { mx = fmaxf(mx, x[i]); mn = fminf(mn, x[i]); }
    mx = wave_max_dpp(mx); mn = -wave_max_dpp(-mn);
    float lo = mn - 1.0f, hi = mx;
    for (int it = 0; it < 48; ++it) {
        const float mid = 0.5f * (lo + hi);
        int cnt = 0;
#pragma unroll
        for (int i = 0; i < NV; ++i) cnt += __popcll(__ballot(x[i] > mid));
        if (cnt == 16) { lo = mid; break; }
        if (cnt > 16) lo = mid; else hi = mid;
    }
    return lo;
}
__device__ __forceinline__ void topk_thresh2(const float (&x)[2], const float (&y)[2], float& lox, float& loy) {
    const float mxx = wave_max_dpp(fmaxf(x[0], x[1])), mnx = -wave_max_dpp(-fminf(x[0], x[1]));
    const float mxy = wave_max_dpp(fmaxf(y[0], y[1])), mny = -wave_max_dpp(-fminf(y[0], y[1]));
    float lx = mnx - 1.0f, hx = mxx, ly = mny - 1.0f, hy = mxy; bool dx = false, dy = false;
    for (int it = 0; it < 48; ++it) {
        const float mdx = 0.5f * (lx + hx), mdy = 0.5f * (ly + hy);
        const int cx = __popcll(__ballot(x[0] > mdx)) + __popcll(__ballot(x[1] > mdx));
        const int cy = __popcll(__ballot(y[0] > mdy)) + __popcll(__ballot(y[1] > mdy));
        if (!dx) { if (cx >= 16) lx = mdx; else hx = mdx; dx = (cx == 16); }
        if (!dy) { if (cy >= 16) ly = mdy; else hy = mdy; dy = (cy == 16); }
        if (dx && dy) break;
    }
    lox = lx; loy = ly;
}
__device__ __forceinline__ int lane_prefix(unsigned long long m) { return __builtin_amdgcn_mbcnt_hi((unsigned)(m >> 32), __builtin_amdgcn_mbcnt_lo((unsigned)m, 0u)); }

template <int N> __device__ __forceinline__ float lane_topk_thresh(const float (&x)[N]) {
    float mx = x[0], mn = x[0];
#pragma unroll
    for (int j = 1; j < N; ++j) { mx = fmaxf(mx, x[j]); mn = fminf(mn, x[j]); }
    float lo = mn - 1.0f, hi = mx; bool done = false;
    for (int it = 0; it < 30; ++it) {
        const float mid = 0.5f * (lo + hi); int cnt = 0;
#pragma unroll
        for (int j = 0; j < N; ++j) cnt += (x[j] > mid) ? 1 : 0;
        if (!done) { if (cnt >= 16) lo = mid; else hi = mid; done = (cnt == 16); }
        if (__all(done)) break;
    }
    return lo;
}
#define CX(i, j) { const bool sw_ = v[i] < v[j]; const float tv_ = sw_ ? v[j] : v[i]; v[j] = sw_ ? v[i] : v[j]; v[i] = tv_; const int ti_ = sw_ ? id[j] : id[i]; id[j] = sw_ ? id[i] : id[j]; id[i] = ti_; }
__device__ __forceinline__ void sort16_desc(float (&v)[16], int (&id)[16]) {
    CX(0,1) CX(2,3) CX(0,2) CX(1,3) CX(1,2) CX(4,5) CX(6,7) CX(4,6) CX(5,7) CX(5,6) CX(0,4) CX(2,6) CX(2,4) CX(1,5) CX(3,7) CX(3,5) CX(1,2) CX(3,4) CX(5,6) CX(8,9) CX(10,11) CX(8,10) CX(9,11) CX(9,10) CX(12,13) CX(14,15) CX(12,14) CX(13,15) CX(13,14) CX(8,12) CX(10,14) CX(10,12) CX(9,13) CX(11,15) CX(11,13) CX(9,10) CX(11,12) CX(13,14) CX(0,8) CX(4,12) CX(4,8) CX(2,10) CX(6,14) CX(6,10) CX(2,4) CX(6,8) CX(10,12) CX(1,9) CX(5,13) CX(5,9) CX(3,11) CX(7,15) CX(7,11) CX(3,5) CX(7,9) CX(11,13) CX(1,2) CX(3,4) CX(5,6) CX(7,8) CX(9,10) CX(11,12) CX(13,14)
}
#undef CX

__device__ __forceinline__ void phase10(const Args& a, LAS unsigned char* lds, int bid, int nb, int tid) {
    const float* SC = (const float*)(a.ws + WS_PROJ); unsigned short* IDC = (unsigned short*)(a.ws + WS_IDC); unsigned short* TK = (unsigned short*)(a.ws + WS_TK); float* GATEC = (float*)(a.ws + WS_GATEC);
    unsigned short* LISTG = (unsigned short*)(a.ws + WS_LIST); int* OFFS = (int*)(a.ws + WS_OFFS); int* CNT = (int*)(a.ws + WS_OFFS + 65536);
    LAS float* slotv = (LAS float*)lds;
    LAS int* sloti = (LAS int*)(lds + 32768);
    LAS int* tids = (LAS int*)(lds + 65536);
    LAS float* tgate = (LAS float*)(lds + 81920);
    LAS int* cnt = (LAS int*)(lds + 98304);
    for (int B = bid; B < 256; B += nb) {
        if (tid < 256) cnt[tid] = 0;
        {
            const int half = tid >> 8, item = tid & 255, tokl = item >> 3, h = item & 7;
            const float* sp = SC + (size_t)(B * 32 + tokl) * D + half * 1024 + h * 128;
            float x[128];
#pragma unroll
            for (int j = 0; j < 32; ++j) { const f32x4 v = *(const f32x4*)(sp + 4 * j); x[4 * j] = v[0]; x[4 * j + 1] = v[1]; x[4 * j + 2] = v[2]; x[4 * j + 3] = v[3]; }
            const float lo = lane_topk_thresh<128>(x);
            int pos = 0;
#pragma unroll
            for (int j = 0; j < 128; ++j) { const bool p = (x[j] > lo) && (pos < 16); if (p) { slotv[pos * 512 + tid] = x[j]; sloti[pos * 512 + tid] = j; } pos += p ? 1 : 0; }
        }
        __syncthreads();
        if (tid < 256) {
            const int tokl = tid >> 3, h = tid & 7;
            float v1[16], v2[16]; int i1[16], i2[16];
#pragma unroll
            for (int j = 0; j < 16; ++j) { v1[j] = slotv[j * 512 + tid]; i1[j] = sloti[j * 512 + tid]; v2[j] = slotv[j * 512 + 256 + tid]; i2[j] = sloti[j * 512 + 256 + tid]; }
            sort16_desc(v1, i1); sort16_desc(v2, i2);
            constexpr int CA[50] = {0,0,0,0,0,0,0,0,0,0,0,0,0,0,0,0, 1,1,1,1,1,1,1,1, 2,2,2,2,2, 3,3,3,3, 4,4,4, 5,5, 6,6, 7,7, 8,9,10,11,12,13,14,15};
            constexpr int CB[50] = {0,1,2,3,4,5,6,7,8,9,10,11,12,13,14,15, 0,1,2,3,4,5,6,7, 0,1,2,3,4, 0,1,2,3, 0,1,2, 0,1, 0,1, 0,1, 0,0,0,0,0,0,0,0};
            float cd[50];
#pragma unroll
            for (int c = 0; c < 50; ++c) cd[c] = v1[CA[c]] + v2[CB[c]];
            const float lo = lane_topk_thresh<50>(cd);
            int pos = 0;
#pragma unroll
            for (int c = 0; c < 50; ++c) { const bool p = (cd[c] > lo) && (pos < 16); if (p) { slotv[pos * 512 + tid] = cd[c]; sloti[pos * 512 + tid] = i1[CA[c]] * 128 + i2[CB[c]]; } pos += p ? 1 : 0; }
            float sc[16]; float m = -INFINITY;
#pragma unroll
            for (int j = 0; j < 16; ++j) { sc[j] = slotv[j * 512 + tid]; m = fmaxf(m, sc[j]); }
            float sum = 0.f;
#pragma unroll
            for (int j = 0; j < 16; ++j) { sc[j] = __expf(sc[j] - m); sum += sc[j]; }
            const float inv = 1.f / sum;
#pragma unroll
            for (int j = 0; j < 16; ++j) { tgate[tokl * 128 + h * 16 + j] = sc[j] * inv; tids[tokl * 128 + h * 16 + j] = sloti[j * 512 + tid]; }
        }
        __syncthreads();
#pragma unroll
        for (int q = 0; q < 8; ++q) { const int idx = tid + q * 512; atomicAdd((int*)(cnt + (idx >> 11) * 128 + (tids[idx] >> 10)), 1); }
        __syncthreads();
        if (tid < 2) { int run = 0; for (int g = 0; g < 16; ++g) { cnt[tid * 128 + 64 + g] = run; run += cnt[tid * 128 + g]; } cnt[tid * 128 + 64 + 16] = run; }
        __syncthreads();
#pragma unroll
        for (int q = 0; q < 8; ++q) { const int idx = tid + q * 512, tt = idx >> 11, il = idx & 2047, id = tids[idx], g = id >> 10, T = B * 2 + tt; const int i = atomicAdd((int*)(cnt + tt * 128 + 32 + g), 1);
            LISTG[((size_t)(g * 512 + T)) * 2048 + (i & 15) * 128 + (i >> 4)] = (unsigned short)((id & 1023) | ((il >> 7) << 10));
            const size_t cp = (size_t)T * 2048 + cnt[tt * 128 + 64 + g] + i;
            IDC[cp] = (unsigned short)id; TK[cp] = (unsigned short)il; GATEC[cp] = tgate[idx]; }
        if (tid < 34) { const int tt = tid / 17, gg = tid % 17; OFFS[(B * 2 + tt) * 17 + gg] = cnt[tt * 128 + 64 + gg]; }
        if (tid < 32) { const int tt = tid >> 4, gg = tid & 15; CNT[gg * 512 + B * 2 + tt] = cnt[tt * 128 + gg]; }
        __syncthreads();
    }
}

struct UStage { int n, off0; u32x4 e0, e1, h0, h1; };
__device__ __forceinline__ long pk64(unsigned lo, unsigned hi) { return (long)(((unsigned long long)hi << 32) | (unsigned long long)lo); }
#define U_LOAD(st, T_) do { const int T__ = (T_); \
    (st).n = CNT[g * 512 + T__]; (st).off0 = OFFS[T__ * 17 + g]; \
    const unsigned short* lp_ = LISTG + ((size_t)(g * 512 + T__)) * 2048 + fr * 128; (st).e0 = *(const u32x4*)lp_; (st).e1 = *(const u32x4*)(lp_ + 8); \
    const unsigned char* hp_ = H2Q + (size_t)(T__ * 16 + fr) * D + sl * 128 + kq * 32; (st).h0 = *(const u32x4*)hp_; (st).h1 = *(const u32x4*)(hp_ + 16); } while (0)
#define U_RD(ent_, b0_, b1_) const int eA_##b0_ = (int)((ent_) & 1023u); \
    const u32x4 b0_ = *(const LAS u32x4*)(lds + eA_##b0_ * 128 + (((2 * kq) ^ (eA_##b0_ & 7)) << 4)), b1_ = *(const LAS u32x4*)(lds + eA_##b0_ * 128 + (((2 * kq + 1) ^ (eA_##b0_ & 7)) << 4));
#define U_MM(acc_, st, b0_, b1_) \
    acc_ = __builtin_amdgcn_mfma_f32_16x16x32_fp8_fp8(pk64((st).h0.x, (st).h0.y), pk64(b0_.x, b0_.y), acc_, 0, 0, 0); \
    acc_ = __builtin_amdgcn_mfma_f32_16x16x32_fp8_fp8(pk64((st).h0.z, (st).h0.w), pk64(b0_.z, b0_.w), acc_, 0, 0, 0); \
    acc_ = __builtin_amdgcn_mfma_f32_16x16x32_fp8_fp8(pk64((st).h1.x, (st).h1.y), pk64(b1_.x, b1_.y), acc_, 0, 0, 0); \
    acc_ = __builtin_amdgcn_mfma_f32_16x16x32_fp8_fp8(pk64((st).h1.z, (st).h1.w), pk64(b1_.z, b1_.w), acc_, 0, 0, 0);
#define U_ST(acc_, ent_, sidx_, pbase_, nn_) do { const int tc = (int)((ent_) >> 10) & 15; const float v01 = (tc & 1) ? acc_[1] : acc_[0], v23 = (tc & 1) ? acc_[3] : acc_[2]; const float val = (tc & 2) ? v23 : v01; \
    float* dst_ = ((sidx_) * 16 + fr < (nn_) && (tc >> 2) == kq) ? (pbase_) + (sidx_) * 16 + fr : trash; *dst_ = val * (1.0f / 64.0f); } while (0)
#define U_PAIR(st, pbase_, nn_, sp_, ew_) do { if ((nn_) > 32 * (sp_)) { \
    const unsigned entA = (ew_) & 0xffffu, entB = (ew_) >> 16; \
    U_RD(entA, bA0, bA1) U_RD(entB, bB0, bB1) \
    f32x4 accA = {0.f, 0.f, 0.f, 0.f}, accB = {0.f, 0.f, 0.f, 0.f}; \
    U_MM(accA, st, bA0, bA1) U_MM(accB, st, bB0, bB1) \
    U_ST(accA, entA, 2 * (sp_), pbase_, nn_); U_ST(accB, entB, 2 * (sp_) + 1, pbase_, nn_); } } while (0)
#define U_PROC(st, T_) do { const int nn = __builtin_amdgcn_readfirstlane((st).n); float* pbase = PART + ((size_t)sl * 512 + (T_)) * 2048 + (st).off0; \
    U_PAIR(st, pbase, nn, 0, (st).e0.x); U_PAIR(st, pbase, nn, 1, (st).e0.y); U_PAIR(st, pbase, nn, 2, (st).e0.z); U_PAIR(st, pbase, nn, 3, (st).e0.w); \
    U_PAIR(st, pbase, nn, 4, (st).e1.x); U_PAIR(st, pbase, nn, 5, (st).e1.y); U_PAIR(st, pbase, nn, 6, (st).e1.z); U_PAIR(st, pbase, nn, 7, (st).e1.w); \
    if (nn > 256) { const unsigned short* lp2 = LISTG + ((size_t)(g * 512 + (T_))) * 2048 + fr * 128;     \
        for (int s2 = 16; s2 * 16 < nn; ++s2) { const unsigned entC = lp2[s2]; U_RD(entC, bC0, bC1) f32x4 accC = {0.f, 0.f, 0.f, 0.f}; U_MM(accC, st, bC0, bC1) U_ST(accC, entC, s2, pbase, nn); } } } while (0)

__device__ __forceinline__ void phase11(const Args& a, LAS unsigned char* lds, int bid, int nb, int tid) {
    unsigned char* ws = a.ws;
    const unsigned char* H2Q = ws + WS_H2Q; const unsigned char* UQ = ws + WS_UQ; const unsigned short* LISTG = (const unsigned short*)(ws + WS_LIST);
    const int* OFFS = (const int*)(ws + WS_OFFS); const int* CNT = (const int*)(ws + WS_OFFS + 65536);
    float* PART = (float*)(ws + WS_PART); float* trash = (float*)(ws + WS_TRASH) + tid;
    const int w = tid >> 6, lane = tid & 63, fr = lane & 15, kq = lane >> 4;
    for (int item = bid; item < 256; item += nb) {
        const int g = item >> 4, sl = item & 15;
        {
            const unsigned char* src = UQ + (size_t)item * 131072;
#pragma unroll
            for (int i = 0; i < 16; ++i) { const int off = (tid + i * 512) * 16; *(LAS u32x4*)(lds + off) = *(const u32x4*)(src + off); }
        }
        __syncthreads();
        for (int T = w; T < 512; T += 32) {
            UStage sA, sB, sC, sD;
            U_LOAD(sA, T); U_LOAD(sB, T + 8); U_LOAD(sC, T + 16); U_LOAD(sD, T + 24);
            U_PROC(sA, T); U_PROC(sB, T + 8); U_PROC(sC, T + 16); U_PROC(sD, T + 24);
        }
        __syncthreads();
    }
}

__device__ __forceinline__ void phase12(const Args& a, LAS unsigned char* lds, int bid, int nb, int tid) {
    unsigned char* ws = a.ws;
    const float* PART = (const float*)(ws + WS_PART); const unsigned short* IDC = (const unsigned short*)(ws + WS_IDC); const unsigned short* TK = (const unsigned short*)(ws + WS_TK);
    const float* GATEC = (const float*)(ws + WS_GATEC); unsigned* PAIRV = (unsigned*)(ws + WS_PAIRV);
    LAS unsigned* tile = (LAS unsigned*)lds;
    for (int T = bid; T < 512; T += nb) {
        const size_t base = (size_t)T * 2048 + tid * 4;
        f32x4 s0 = {0.f, 0.f, 0.f, 0.f};
#pragma unroll
        for (int sl = 0; sl < 16; ++sl) s0 += *(const f32x4*)(PART + (size_t)sl * 512 * 2048 + base);
        const u32x2 iw = *(const u32x2*)(IDC + base), tw = *(const u32x2*)(TK + base); const f32x4 gt = *(const f32x4*)(GATEC + base);
        int id[4], tk[4]; id[0] = iw.x & 0xffff; id[1] = iw.x >> 16; id[2] = iw.y & 0xffff; id[3] = iw.y >> 16; tk[0] = tw.x & 0xffff; tk[1] = tw.x >> 16; tk[2] = tw.y & 0xffff; tk[3] = tw.y >> 16;
#pragma unroll
        for (int j = 0; j < 4; ++j) {
            const float act = s0[j];
            tile[(tk[j] & 127) * 17 + (tk[j] >> 7)] = (unsigned)id[j] | (cvt_pk_bf16(0.f, gt[j] * gelu_erf(act)) & 0xffff0000u);
        }
        __syncthreads();
#pragma unroll
        for (int q = 0; q < 4; ++q) { const int idx = tid + q * 512, k = idx >> 4, tt = idx & 15; PAIRV[(size_t)k * S + T * 16 + tt] = tile[k * 17 + tt]; }
        __syncthreads();
    }
}

__device__ __forceinline__ void phase13(const Args& a, LAS unsigned char* lds, int bid, int nb, int tid) {
    unsigned char* ws = a.ws;
    const unsigned* PAIRV = (const unsigned*)(ws + WS_PAIRV); const unsigned char* VQ = ws + WS_VQ; bf16_t* FFNT = (bf16_t*)(ws + WS_FFNT);
    const int w = tid >> 6, lane = tid & 63;
    for (int c = bid; c < 256; c += nb) {
        {
            const unsigned char* src = VQ + (size_t)c * 131072;
#pragma unroll
            for (int i = 0; i < 16; ++i) { const int off = (tid + i * 512) * 16; *(LAS u32x4*)(lds + off) = *(const u32x4*)(src + off); }
        }
        __syncthreads();
        for (int task = w; task < 32; task += 8) {
            const int t4 = task * 256 + lane * 4;
            f32x2 acc[4][4];
#pragma unroll
            for (int q = 0; q < 4; ++q)
#pragma unroll
                for (int j = 0; j < 4; ++j) acc[q][j] = (f32x2){0.f, 0.f};
            const unsigned* pp = PAIRV + t4;
            constexpr int NB = 16;
            u32x4 pr[NB];
#pragma unroll
            for (int j = 0; j < NB; ++j) pr[j] = *(const u32x4*)(pp + (size_t)j * S);
            for (int kb = 0; kb < 128 / NB; ++kb) {
                u32x4 nx[NB];
                const int kn = (kb < 128 / NB - 1 ? kb + 1 : kb) * NB;
#pragma unroll
                for (int j = 0; j < NB; ++j) nx[j] = *(const u32x4*)(pp + (size_t)(kn + j) * S);
                u32x2 vv[2][4];
#pragma unroll
                for (int q = 0; q < 4; ++q) vv[0][q] = *(const LAS u32x2*)(lds + ((pr[0][q] & 0xffffu) << 3));
#pragma unroll
                for (int j = 0; j < NB; ++j) {
                    if (j < NB - 1) {
#pragma unroll
                        for (int q = 0; q < 4; ++q) vv[(j + 1) & 1][q] = *(const LAS u32x2*)(lds + ((pr[j + 1][q] & 0xffffu) << 3));
                    }
#pragma unroll
                    for (int q = 0; q < 4; ++q) {
                        const float coef = __uint_as_float(pr[j][q] & 0xffff0000u); const u32x2 v = vv[j & 1][q];
                        acc[q][0] += __builtin_amdgcn_cvt_pk_f32_fp8((int)v.x, false) * coef; acc[q][1] += __builtin_amdgcn_cvt_pk_f32_fp8((int)v.x, true) * coef;
                        acc[q][2] += __builtin_amdgcn_cvt_pk_f32_fp8((int)v.y, false) * coef; acc[q][3] += __builtin_amdgcn_cvt_pk_f32_fp8((int)v.y, true) * coef;
                    }
                }
#pragma unroll
                for (int j = 0; j < NB; ++j) pr[j] = nx[j];
            }
#pragma unroll
            for (int q = 0; q < 4; ++q) { u32x4 o; o.x = cvt_pk_bf16(acc[q][0].x, acc[q][0].y); o.y = cvt_pk_bf16(acc[q][1].x, acc[q][1].y); o.z = cvt_pk_bf16(acc[q][2].x, acc[q][2].y); o.w = cvt_pk_bf16(acc[q][3].x, acc[q][3].y);
                *(u32x4*)(FFNT + ((size_t)c * S + t4 + q) * 8) = o; }
        }
        __syncthreads();
    }
}

__device__ __forceinline__ void phase14(const Args& a, int bid, int nb, int tid) {
    unsigned char* ws = a.ws;
    const float* X1 = (const float*)(ws + WS_PRE1); const bf16_t* FFNT = (const bf16_t*)(ws + WS_FFNT); const float* mod = (const float*)(ws + WS_MOD);
    const float* gam = a.in[I_LN2G]; const float* bet = a.in[I_LN2B]; float* out = a.out;
    const int wave = tid >> 6, lane = tid & 63;
    for (int tok = bid * 8 + wave; tok < S; tok += nb * 8) {
        float acc[32];
#pragma unroll
        for (int j = 0; j < 4; ++j) { const u32x4 v = *(const u32x4*)(FFNT + ((size_t)(lane + 64 * j) * S + tok) * 8);
            acc[8 * j + 0] = bf_lo(v.x); acc[8 * j + 1] = bf_hi(v.x); acc[8 * j + 2] = bf_lo(v.y); acc[8 * j + 3] = bf_hi(v.y); acc[8 * j + 4] = bf_lo(v.z); acc[8 * j + 5] = bf_hi(v.z); acc[8 * j + 6] = bf_lo(v.w); acc[8 * j + 7] = bf_hi(v.w); }
        float s = 0.f;
#pragma unroll
        for (int j = 0; j < 4; ++j) { const int col = 8 * lane + 512 * j;
            const f32x4 xa = *(const f32x4*)(X1 + (size_t)tok * D + col), xb = *(const f32x4*)(X1 + (size_t)tok * D + col + 4);
            const f32x4 ga = *(const f32x4*)(mod + 5 * D + col), gb = *(const f32x4*)(mod + 5 * D + col + 4);
#pragma unroll
            for (int i = 0; i < 4; ++i) { acc[8 * j + i] = ALPHA * xa[i] + (1.f + ga[i]) * acc[8 * j + i]; acc[8 * j + 4 + i] = ALPHA * xb[i] + (1.f + gb[i]) * acc[8 * j + 4 + i]; }
#pragma unroll
            for (int i = 0; i < 8; ++i) s += acc[8 * j + i]; }
        const float mean = wave_sum(s) * (1.f / D); float q = 0.f;
#pragma unroll
        for (int i = 0; i < 32; ++i) { acc[i] -= mean; q += acc[i] * acc[i]; }
        const float rstd = rsqrtf(wave_sum(q) * (1.f / D) + LN_EPS);
#pragma unroll
        for (int j = 0; j < 4; ++j) { const int col = 8 * lane + 512 * j;
            const f32x4 ga = *(const f32x4*)(gam + col), gb = *(const f32x4*)(gam + col + 4), ba = *(const f32x4*)(bet + col), bb = *(const f32x4*)(bet + col + 4);
            f32x4 oa, ob;
#pragma unroll
            for (int i = 0; i < 4; ++i) { oa[i] = acc[8 * j + i] * rstd * ga[i] + ba[i]; ob[i] = acc[8 * j + 4 + i] * rstd * gb[i] + bb[i]; }
            *(f32x4*)(out + (size_t)tok * D + col) = oa; *(f32x4*)(out + (size_t)tok * D + col + 4) = ob; }
    }
}

__global__ void __launch_bounds__(512, 2) mega(Args args) {
    extern __shared__ __attribute__((aligned(16))) unsigned char lds_raw[];
    LAS unsigned char* lds = (LAS unsigned char*)lds_raw;
    const int tid = threadIdx.x, bid = blockIdx.x, nb = gridDim.x;
    const int lo = args.ph_lo, hi = args.ph_hi;
    unsigned char* ws = args.ws;
    volatile LAS unsigned* MISC = (volatile LAS unsigned*)(lds + LDS_BYTES - 64);
    XcdBarrier bar; bar.bar = (unsigned*)(ws + WS_CTL); bar.x = 0; bar.st = nullptr;
    if (hi - lo > 1) {
        if (tid < 16) MISC[tid] = 0u;
        __syncthreads();
        bar = xcd_barrier_post((unsigned*)(ws + WS_CTL), MISC + 8);
    }
#define IN(k) (lo <= (k) && (k) < hi)
#define SEAM(k) do { if (IN(k) && IN((k) + 1)) xcd_barrier(bar); } while (0)
    if (IN(0)) { phase0(args, lds, bid, nb, tid); } SEAM(0);
    if (IN(1)) { phase1(args, bid, nb, tid); } SEAM(1);
    if (IN(2)) { phase2(args, bid, nb, tid); } SEAM(2);
    if (IN(3)) {
        pg8::Gemm g{(const bf16_t*)(ws + WS_H), (const bf16_t*)(ws + WS_WIN), S, NINP, D}; pg8::StaticOrder so; so.init(S, NINP, nb, bid);
        pg8::EpiProj E{(bf16_t*)(ws + WS_PROJ), (float*)(ws + WS_DT), args.in[I_DTB]};
        pg8::gemm_phase<pg8::EpiProj, pg8::StaticOrder, true, true>(lds, g, so, E);
    } SEAM(3);
    if (IN(4)) {
        for (int item = bid; item < 1280; item += nb) {
            if (item < 256) ssda_item(args, lds, item >> 2, (item >> 1) & 1, item & 1, tid);
            else attn_item(args, lds, (item - 256) >> 4, (item - 256) & 15, tid);
        }
    } SEAM(4);
    if (IN(5)) { phase5(args, bid, nb, tid); } SEAM(5);
    if (IN(6)) { for (int item = bid; item < 256; item += nb) ssdb_item(args, lds, item >> 1, item & 1, tid); } SEAM(6);
    if (IN(7)) {
        pg8::Gemm g{(const bf16_t*)(ws + WS_MIXIN), (const bf16_t*)(ws + WS_WOUT), S, D, D}; pg8::StaticOrder so; so.init(S, D, nb, bid);
        pg8::EpiPre1 E{args.in[I_X], (const float*)(ws + WS_MOD) + 2 * D, (float*)(ws + WS_PRE1)};
        pg8::gemm_phase<pg8::EpiPre1, pg8::StaticOrder, true, true>(lds, g, so, E);
    } SEAM(7);
    if (IN(8)) { phase8(args, bid, nb, tid); } SEAM(8);
    if (IN(9)) {
        pg8::Gemm g{(const bf16_t*)(ws + WS_H), (const bf16_t*)(ws + WS_WSC), S, D, D}; pg8::StaticOrder so; so.init(S, D, nb, bid);
        pg8::EpiF32 E{(float*)(ws + WS_PROJ), D};
        pg8::gemm_phase<pg8::EpiF32, pg8::StaticOrder, true, true>(lds, g, so, E);
    } SEAM(9);
    if (IN(10)) { phase10(args, lds, bid, nb, tid); } SEAM(10);
    if (IN(11)) { phase11(args, lds, bid, nb, tid); } SEAM(11);
    if (IN(12)) { phase12(args, lds, bid, nb, tid); } SEAM(12);
    if (IN(13)) { phase13(args, lds, bid, nb, tid); } SEAM(13);
    if (IN(14)) { phase14(args, bid, nb, tid); }
#undef IN
#undef SEAM
}

extern "C" void kernel_launch(void* const* d_in, const int* in_sizes, int n_in, void* d_out, int out_size, void* d_ws, size_t ws_size, hipStream_t stream) {
    static int grid = 0;
    if (grid == 0) {
        if (n_in != 23 || in_sizes[0] != S * D || out_size != S * D || ws_size < WS_END) { fprintf(stderr, "kernel_launch: unexpected shapes (n_in %d, in0 %d, out %d, ws %zu)\n", n_in, n_in > 0 ? in_sizes[0] : -1, out_size, ws_size); grid = -1; return; }
        int dev = 0, cus = 0, per_cu = 0;
        if (hipGetDevice(&dev) != hipSuccess || hipDeviceGetAttribute(&cus, hipDeviceAttributeMultiprocessorCount, dev) != hipSuccess) { grid = -1; return; }
        if (hipFuncSetAttribute((const void*)mega, hipFuncAttributeMaxDynamicSharedMemorySize, LDS_BYTES) != hipSuccess) { fprintf(stderr, "kernel_launch: hipFuncSetAttribute failed\n"); grid = -1; return; }
        if (hipOccupancyMaxActiveBlocksPerMultiprocessor(&per_cu, (const void*)mega, 512, LDS_BYTES) != hipSuccess || per_cu < 1) { fprintf(stderr, "kernel_launch: occupancy query says %d blocks/CU\n", per_cu); (void)hipGetLastError(); grid = -1; return; }
        grid = cus;
    }
    if (grid < 0) return;
    (void)hipMemsetAsync((char*)d_ws + WS_CTL, 0, CTL_ZERO_BYTES, stream);
    Args a{};
    for (int i = 0; i < 23; ++i) a.in[i] = (const float*)d_in[i];
    a.out = (float*)d_out; a.ws = (unsigned char*)d_ws;
    constexpr int NL = MK_N_LAUNCHES;
    for (int li = 0; li < NL; ++li) {
        a.ph_lo = (NL == NPH) ? li : (li * NPH) / NL; a.ph_hi = (NL == NPH) ? li + 1 : ((li + 1) * NPH) / NL;
        hipLaunchKernelGGL(mega, dim3(grid), dim3(512), LDS_BYTES, stream, a);
    }
}
```
